# Optimizing an MI355X kernel written in HIP

```python
import math
import jax, jax.numpy as jnp
from jax import lax
import numpy as np

D_MODEL = 1024
BATCH = 4
SEQ = 8192
DEPTH = 4

N_EVEN = (DEPTH + 1) // 2
N_ODD = DEPTH // 2
EPS = 1e-6
ROPE_THETA = 500000.0
Q_BLOCK = 128
D_FF = 2816
MIX_WIDTH = D_MODEL

MLA_HEADS = 4
MLA_NOPE = 128
MLA_ROPE = 64
MLA_V = 128
MLA_Q_RANK = 512
MLA_KV_RANK = 256
MLA_WIDTH = MLA_HEADS * MLA_V

S5_WIDTH = MIX_WIDTH - MLA_WIDTH
S5_GROUP = 16
S5_GROUPS = S5_WIDTH // S5_GROUP
S5_STATE = 64
DT_MIN = 1e-3
DT_MAX = 1e-1

HY_IN = MLA_Q_RANK + MLA_KV_RANK + MLA_ROPE + S5_WIDTH

DIFF_HEADS = 8
DIFF_HEAD_DIM = 64
DIFF_ROT = DIFF_HEAD_DIM // 4
DIFF_HW = DIFF_HEADS * 2 * DIFF_HEAD_DIM
DIFF_IN = 3 * DIFF_HW

kernel_name = "hybrid_mla_s5_diffattn_macaron_encoder"


def rmsnorm(x, g):
    xf = x.astype(jnp.float32)
    y = xf * lax.rsqrt(jnp.mean(xf * xf, axis=-1, keepdims=True) + EPS)
    return (y * g.astype(jnp.float32)).astype(x.dtype)


def rope_tables(seq, rot):
    pos = jnp.arange(seq, dtype=jnp.float32)
    inv = ROPE_THETA ** (-jnp.arange(0, rot, 2, dtype=jnp.float32) / rot)
    ang = pos[:, None] * inv[None, :]
    return jnp.cos(ang), jnp.sin(ang)


def apply_rope(x, cos, sin):
    shape = (1, cos.shape[0]) + (1,) * (x.ndim - 3) + (cos.shape[1],)
    c = cos.reshape(shape)
    s = sin.reshape(shape)
    xf = x.astype(jnp.float32)
    x1, x2 = jnp.split(xf, 2, axis=-1)
    return jnp.concatenate([x1 * c - x2 * s, x2 * c + x1 * s], axis=-1).astype(x.dtype)


def swiglu(h, wg, wu, wd):
    return (jax.nn.silu(h @ wg) * (h @ wu)) @ wd


def sweep_query_blocks(fn, q):
    b, s = q.shape[:2]
    nb = s // Q_BLOCK
    qb = jnp.moveaxis(q.reshape((b, nb, Q_BLOCK) + q.shape[2:]), 1, 0)
    ob = lax.map(fn, qb)
    return jnp.moveaxis(ob, 0, 1).reshape((b, s) + ob.shape[3:])


def mla_mixer(z_q, z_kv, z_kr, q_norm, w_q_up, kv_norm, w_kv_up, cos, sin):
    b, s, _ = z_q.shape
    q = (rmsnorm(z_q, q_norm) @ w_q_up).reshape(b, s, MLA_HEADS, MLA_NOPE + MLA_ROPE)
    q = jnp.concatenate([q[..., :MLA_NOPE], apply_rope(q[..., MLA_NOPE:], cos, sin)], axis=-1)
    kv = (rmsnorm(z_kv, kv_norm) @ w_kv_up).reshape(b, s, MLA_HEADS, MLA_NOPE + MLA_V)
    k_nope, v = kv[..., :MLA_NOPE], kv[..., MLA_NOPE:]
    k_pe = apply_rope(z_kr[:, :, None, :], cos, sin)
    k = jnp.concatenate([k_nope, jnp.broadcast_to(k_pe, (b, s, MLA_HEADS, MLA_ROPE))], axis=-1)
    scale = (MLA_NOPE + MLA_ROPE) ** -0.5

    def block(qb):
        sc = jnp.einsum('bqhd,bkhd->bhqk', qb, k, preferred_element_type=jnp.float32) * scale
        p = jax.nn.softmax(sc, axis=-1).astype(v.dtype)
        return jnp.einsum('bhqk,bkhd->bqhd', p, v)

    o = sweep_query_blocks(block, q)
    return o.reshape(b, s, MLA_WIDTH)


def _ssm_combine(e1, e2):
    a1r, a1i, b1r, b1i = e1
    a2r, a2i, b2r, b2i = e2
    return (a1r * a2r - a1i * a2i,
            a1r * a2i + a1i * a2r,
            a2r * b1r - a2i * b1i + b2r,
            a2r * b1i + a2i * b1r + b2i)


def s5_mixer(u, lam_re, lam_im, log_dt, b_re, b_im, c_re, c_im, d, w_glu, b_glu):
    bsz, s, _ = u.shape
    f32 = jnp.float32
    uf = u.astype(f32)
    ug = uf.reshape(bsz, s, S5_GROUPS, S5_GROUP)
    y = d.astype(f32) * uf
    for direction in range(2):
        lr = lam_re[direction].astype(f32)
        li = lam_im[direction].astype(f32)
        dt = jnp.exp(log_dt[direction].astype(f32))[:, None]
        mag = jnp.exp(lr * dt)
        ang = li * dt
        a_re = mag * jnp.cos(ang)
        a_im = mag * jnp.sin(ang)
        den = lr * lr + li * li
        nr = a_re - 1.0
        coef_re = (nr * lr + a_im * li) / den
        coef_im = (a_im * lr - nr * li) / den
        br = b_re[direction].astype(f32)
        bi = b_im[direction].astype(f32)
        bb_re = coef_re[..., None] * br - coef_im[..., None] * bi
        bb_im = coef_re[..., None] * bi + coef_im[..., None] * br
        bu_re = jnp.einsum('bsgc,gpc->sbgp', ug, bb_re)
        bu_im = jnp.einsum('bsgc,gpc->sbgp', ug, bb_im)
        a_re_t = jnp.broadcast_to(a_re[None, None], (s, 1, S5_GROUPS, S5_STATE))
        a_im_t = jnp.broadcast_to(a_im[None, None], (s, 1, S5_GROUPS, S5_STATE))
        _, _, x_re, x_im = lax.associative_scan(
            _ssm_combine, (a_re_t, a_im_t, bu_re, bu_im), axis=0, reverse=(direction == 1))
        out = (jnp.einsum('sbgp,gcp->bsgc', x_re, c_re[direction].astype(f32))
               - jnp.einsum('sbgp,gcp->bsgc', x_im, c_im[direction].astype(f32)))
        y = y + out.reshape(bsz, s, S5_WIDTH)
    y = jax.nn.gelu(y)
    y = y * jax.nn.sigmoid(y @ w_glu.astype(f32) + b_glu.astype(f32))
    return y.astype(u.dtype)


def diff_mixer(z, lq1, lk1, lq2, lk2, subln, lam_init, cos, sin):
    b, s, _ = z.shape
    q = z[..., :DIFF_HW].reshape(b, s, DIFF_HEADS, 2, DIFF_HEAD_DIM)
    k = z[..., DIFF_HW:2 * DIFF_HW].reshape(b, s, DIFF_HEADS, 2, DIFF_HEAD_DIM)
    v = z[..., 2 * DIFF_HW:].reshape(b, s, DIFF_HEADS, 2 * DIFF_HEAD_DIM)
    q = jnp.concatenate([apply_rope(q[..., :DIFF_ROT], cos, sin), q[..., DIFF_ROT:]], axis=-1)
    k = jnp.concatenate([apply_rope(k[..., :DIFF_ROT], cos, sin), k[..., DIFF_ROT:]], axis=-1)
    f32 = jnp.float32
    lam = (jnp.exp(jnp.sum(lq1.astype(f32) * lk1.astype(f32)))
           - jnp.exp(jnp.sum(lq2.astype(f32) * lk2.astype(f32))) + lam_init)
    scale = DIFF_HEAD_DIM ** -0.5

    def block(qb):
        sc = jnp.einsum('bqhmd,bkhmd->bhmqk', qb, k, preferred_element_type=jnp.float32) * scale
        p = jax.nn.softmax(sc, axis=-1)
        a = (p[:, :, 0] - lam * p[:, :, 1]).astype(v.dtype)
        return jnp.einsum('bhqk,bkhd->bqhd', a, v)

    o = sweep_query_blocks(block, q)
    o = rmsnorm(o, subln) * (1.0 - lam_init)
    return o.reshape(b, s, DIFF_HW)


def setup_inputs(seed: int = 0) -> dict:
    key = jax.random.key(seed)
    ks = iter(jax.random.split(key, 48))

    def nrm(shape, scale):
        return jax.random.normal(next(ks), shape, jnp.float32) * scale

    def gain(shape):
        return 1.0 + nrm(shape, 0.02)

    x = nrm((BATCH, SEQ, D_MODEL), 1.0)
    inp = {"x": x}
    inp["ffn1_norm"] = gain((DEPTH, D_MODEL))
    inp["ffn1_w_gate"] = nrm((DEPTH, D_MODEL, D_FF), D_MODEL ** -0.5)
    inp["ffn1_w_up"] = nrm((DEPTH, D_MODEL, D_FF), D_MODEL ** -0.5)
    inp["ffn1_w_down"] = nrm((DEPTH, D_FF, D_MODEL), D_FF ** -0.5)
    inp["mix_norm"] = gain((DEPTH, D_MODEL))
    inp["ffn2_norm"] = gain((DEPTH, D_MODEL))
    inp["ffn2_w_gate"] = nrm((DEPTH, D_MODEL, D_FF), D_MODEL ** -0.5)
    inp["ffn2_w_up"] = nrm((DEPTH, D_MODEL, D_FF), D_MODEL ** -0.5)
    inp["ffn2_w_down"] = nrm((DEPTH, D_FF, D_MODEL), D_FF ** -0.5)
    inp["hy_w_in"] = nrm((N_EVEN, D_MODEL, HY_IN), D_MODEL ** -0.5)
    inp["mla_q_norm"] = gain((N_EVEN, MLA_Q_RANK))
    inp["mla_w_q_up"] = nrm((N_EVEN, MLA_Q_RANK, MLA_HEADS * (MLA_NOPE + MLA_ROPE)), MLA_Q_RANK ** -0.5)
    inp["mla_kv_norm"] = gain((N_EVEN, MLA_KV_RANK))
    inp["mla_w_kv_up"] = nrm((N_EVEN, MLA_KV_RANK, MLA_HEADS * (MLA_NOPE + MLA_V)), MLA_KV_RANK ** -0.5)
    n_idx = jnp.arange(S5_STATE, dtype=jnp.float32)
    ssm_shape = (N_EVEN, 2, S5_GROUPS, S5_STATE)
    inp["s5_lambda_re"] = -0.5 + nrm(ssm_shape, 0.01)
    inp["s5_lambda_im"] = jnp.pi * n_idx + nrm(ssm_shape, 0.01)
    inp["s5_log_dt"] = jax.random.uniform(next(ks), (N_EVEN, 2, S5_GROUPS), jnp.float32,
                                          math.log(DT_MIN), math.log(DT_MAX))
    inp["s5_b_re"] = nrm((N_EVEN, 2, S5_GROUPS, S5_STATE, S5_GROUP), S5_GROUP ** -0.5)
    inp["s5_b_im"] = nrm((N_EVEN, 2, S5_GROUPS, S5_STATE, S5_GROUP), S5_GROUP ** -0.5)
    inp["s5_c_re"] = nrm((N_EVEN, 2, S5_GROUPS, S5_GROUP, S5_STATE), S5_STATE ** -0.5)
    inp["s5_c_im"] = nrm((N_EVEN, 2, S5_GROUPS, S5_GROUP, S5_STATE), S5_STATE ** -0.5)
    inp["s5_d"] = nrm((N_EVEN, S5_WIDTH), 1.0)
    inp["s5_w_glu"] = nrm((N_EVEN, S5_WIDTH, S5_WIDTH), S5_WIDTH ** -0.5)
    inp["s5_b_glu"] = nrm((N_EVEN, S5_WIDTH), 0.01)
    inp["hy_w_out"] = nrm((N_EVEN, MIX_WIDTH, D_MODEL), MIX_WIDTH ** -0.5)
    inp["diff_w_in"] = nrm((N_ODD, D_MODEL, DIFF_IN), D_MODEL ** -0.5)
    inp["diff_lambda_q1"] = nrm((N_ODD, DIFF_HEAD_DIM), 0.1)
    inp["diff_lambda_k1"] = nrm((N_ODD, DIFF_HEAD_DIM), 0.1)
    inp["diff_lambda_q2"] = nrm((N_ODD, DIFF_HEAD_DIM), 0.1)
    inp["diff_lambda_k2"] = nrm((N_ODD, DIFF_HEAD_DIM), 0.1)
    inp["diff_subln"] = gain((N_ODD, 2 * DIFF_HEAD_DIM))
    inp["diff_w_out"] = nrm((N_ODD, DIFF_HW, D_MODEL), DIFF_HW ** -0.5)
    inp["final_norm"] = gain((D_MODEL,))
    return inp


def reference(x, ffn1_norm, ffn1_w_gate, ffn1_w_up, ffn1_w_down, mix_norm,
              ffn2_norm, ffn2_w_gate, ffn2_w_up, ffn2_w_down,
              hy_w_in, mla_q_norm, mla_w_q_up, mla_kv_norm, mla_w_kv_up,
              s5_lambda_re, s5_lambda_im, s5_log_dt, s5_b_re, s5_b_im, s5_c_re, s5_c_im,
              s5_d, s5_w_glu, s5_b_glu, hy_w_out,
              diff_w_in, diff_lambda_q1, diff_lambda_k1, diff_lambda_q2, diff_lambda_k2,
              diff_subln, diff_w_out, final_norm):
    s = x.shape[1]
    cos_m, sin_m = rope_tables(s, MLA_ROPE)
    cos_d, sin_d = rope_tables(s, DIFF_ROT)
    o1 = MLA_Q_RANK
    o2 = o1 + MLA_KV_RANK
    o3 = o2 + MLA_ROPE
    for i in range(DEPTH):
        x = x + 0.5 * swiglu(rmsnorm(x, ffn1_norm[i]), ffn1_w_gate[i], ffn1_w_up[i], ffn1_w_down[i])
        h = rmsnorm(x, mix_norm[i])
        j = i // 2
        if i % 2 == 0:
            z = h @ hy_w_in[j]
            o_a = mla_mixer(z[..., :o1], z[..., o1:o2], z[..., o2:o3],
                            mla_q_norm[j], mla_w_q_up[j], mla_kv_norm[j], mla_w_kv_up[j],
                            cos_m, sin_m)
            o_b = s5_mixer(z[..., o3:], s5_lambda_re[j], s5_lambda_im[j], s5_log_dt[j],
                           s5_b_re[j], s5_b_im[j], s5_c_re[j], s5_c_im[j],
                           s5_d[j], s5_w_glu[j], s5_b_glu[j])
            x = x + jnp.concatenate([o_a, o_b], axis=-1) @ hy_w_out[j]
        else:
            lam_init = 0.8 - 0.6 * math.exp(-0.3 * i)
            z = h @ diff_w_in[j]
            o_c = diff_mixer(z, diff_lambda_q1[j], diff_lambda_k1[j], diff_lambda_q2[j],
                             diff_lambda_k2[j], diff_subln[j], lam_init, cos_d, sin_d)
            x = x + o_c @ diff_w_out[j]
        x = x + 0.5 * swiglu(rmsnorm(x, ffn2_norm[i]), ffn2_w_gate[i], ffn2_w_up[i], ffn2_w_down[i])
    return rmsnorm(x, final_norm)
```

```cpp
#include <hip/hip_runtime.h>
#include <hip/hip_cooperative_groups.h>
#include <cstdio>
#include <cstdint>
#include <cstring>
#include <cmath>
namespace cg = cooperative_groups;
namespace pg8 {
#define PG8_LAS __attribute__((address_space(3)))
typedef unsigned short bf16_t;
typedef short bf16x8 __attribute__((ext_vector_type(8)));
typedef float f32x4 __attribute__((ext_vector_type(4)));
typedef unsigned u32x4 __attribute__((ext_vector_type(4)));
constexpr int BM = 256, BK = 64, HALF = 128, HTB = HALF * BK * 2  , STAGE_BYTES = 8 * HTB, NXCD = 8, WGM = 8;

__host__ __device__ __forceinline__ int lds_byte(int r, int c) { const int st = (r >> 4) * 2 + (c >> 5), rr = r & 15, cc = c & 31, ob = rr * 64 + cc * 2; return st * 1024 + (ob ^ (((ob >> 9) & 1) << 5)); }
__host__ __device__ __forceinline__ void stage_rc(int b, int& R, int& C) { const int st = b / 1024, sb = b % 1024, swz = sb ^ (((sb >> 9) & 1) << 5); R = (st >> 1) * 16 + swz / 64; C = (st & 1) * 32 + (swz % 64) / 2; }
__host__ __device__ __forceinline__ int perm32(int rho) { const int n = rho >> 4, i = rho & 15; return 8 * (i >> 2) + 4 * n + (i & 3); }

struct Unit { int pm, pn; };
struct Gemm { const bf16_t* A; const bf16_t* Bt; int M, N, K; };

struct StaticOrder {
    int nM, nN, nwg, G, c;
    __host__ __device__ void init(int M, int N, int G_, int c_) { nM = M / BM; nN = N / BM; nwg = nM * nN; G = G_; c = c_; }
    __host__ __device__ bool next(int i, Unit& u) const {
        const long L = (long)i * G + c; if (L >= nwg) return false;
        int wgid = (int)L; { const int q = nwg / NXCD, r = nwg % NXCD, xcd = wgid % NXCD, off = wgid / NXCD; wgid = (xcd < r ? xcd * (q + 1) : r * (q + 1) + (xcd - r) * q) + off; }
        const int nig = WGM * nN, gid = wgid / nig, fm = gid * WGM, gsz = (nM - fm) < WGM ? (nM - fm) : WGM;
        u.pm = fm + ((wgid % nig) % gsz); u.pn = (wgid % nig) / gsz; return true;
    }
    __device__ __forceinline__ void a_ready(const Unit&) const {}
    __device__ __forceinline__ void done(const Unit&) const {}
};

__device__ __forceinline__ unsigned cvt_pk_bf16(float lo, float hi) { unsigned r; asm volatile("v_cvt_pk_bf16_f32 %0, %1, %2" : "=v"(r) : "v"(lo), "v"(hi)); return r; }
typedef float f32x2 __attribute__((ext_vector_type(2)));
template <class Epi, class Sched, bool ALIGN_EPI = false, bool SP2 = false>
__device__ __forceinline__ void gemm_phase(PG8_LAS unsigned char* lds, const Gemm g, const Sched& S, const Epi& E) {
    int tid_ = threadIdx.x; asm volatile("" : "+v"(tid_)); const int tid = tid_, wid = __builtin_amdgcn_readfirstlane(tid >> 6), lane = tid & 63, wr = wid >> 2, wc = wid & 3, fr = lane & 15, fq = lane >> 4;
    const int K = g.K, nt = K / BK;
    unsigned voffA[2], voffB[2];
#pragma unroll
    for (int i = 0; i < 2; ++i) { int R, C; stage_rc(tid * 16 + i * 8192, R, C); const int Rb = Epi::PERM ? ((R & ~31) + perm32(R & 31)) : R;
        voffA[i] = (unsigned)(R * K + C) * 2u; voffB[i] = (unsigned)(Rb * K + C) * 2u; }
    const size_t kstep = (size_t)(BK * 2);
    const size_t hstep = (size_t)HALF * K * 2;
    const size_t tstep = 2 * hstep;
    const unsigned ldsw = (unsigned)wid * 1024u;
    const int aoff = lds_byte(wr * 64 + fr, fq * 8), boff = lds_byte(wc * 32 + fr, fq * 8);
#define PG8_SA(b, h) (((b) * 2 + (h)) * HTB)
#define PG8_SB(b, h) ((4 + (b) * 2 + (h)) * HTB)
#define PG8_STAGE(bufoff, gbase, voff) do { _Pragma("unroll") for (int _i = 0; _i < 2; ++_i) \
        __builtin_amdgcn_global_load_lds((const unsigned*)((const char*)(gbase) + (voff)[_i]), (PG8_LAS unsigned*)(lds + (bufoff) + ldsw + _i * 8192), 16, 0, 0); } while (0)
#define PG8_LDA(dst, b, h) do { _Pragma("unroll") for (int m = 0; m < 4; ++m) _Pragma("unroll") for (int k = 0; k < 2; ++k) dst[m][k] = *(const PG8_LAS bf16x8*)(lds + PG8_SA(b, h) + aoff + m * 2048 + k * 1024); } while (0)
#define PG8_LDB(dst, b, h) do { _Pragma("unroll") for (int n = 0; n < 2; ++n) _Pragma("unroll") for (int k = 0; k < 2; ++k) dst[n][k] = *(const PG8_LAS bf16x8*)(lds + PG8_SB(b, h) + boff + n * 2048 + k * 1024); } while (0)
#define PG8_MMA(ai, bj, At, Bt) do { __builtin_amdgcn_s_setprio(1); _Pragma("unroll") for (int m = 0; m < 4; ++m) _Pragma("unroll") for (int n = 0; n < 2; ++n) _Pragma("unroll") for (int k = 0; k < 2; ++k) \
        acc[ai][bj][m][n] = __builtin_amdgcn_mfma_f32_16x16x32_bf16(Bt[n][k], At[m][k], acc[ai][bj][m][n], 0, 0, 0); __builtin_amdgcn_s_setprio(0); } while (0)
#define PG8_WAIT_V(n) asm volatile("s_waitcnt vmcnt(" #n ")" ::: "memory")
#define PG8_WAIT_L(n) asm volatile("s_waitcnt lgkmcnt(" #n ")" ::: "memory")
#define PG8_BAR __builtin_amdgcn_s_barrier()
#define PG8_SCHED __builtin_amdgcn_sched_barrier(0)
    Unit cur, nxt; int ui = 0;
    if (!S.next(0, cur)) return;
    f32x4 acc[2][2][4][2];
#pragma unroll
    for (int a = 0; a < 2; ++a)
#pragma unroll
        for (int b = 0; b < 2; ++b)
#pragma unroll
            for (int m = 0; m < 4; ++m)
#pragma unroll
                for (int n = 0; n < 2; ++n) acc[a][b][m][n] = (f32x4){0.f, 0.f, 0.f, 0.f};
    bf16x8 At[4][2], B0[2][2], B1[2][2];
    const char* cA = (const char*)g.A + (size_t)cur.pm * tstep; const char* cB = (const char*)g.Bt + (size_t)cur.pn * tstep;
    S.a_ready(cur);
    if constexpr (SP2) {
        PG8_STAGE(PG8_SB(0, 0), cB, voffB); PG8_STAGE(PG8_SB(0, 1), cB + hstep, voffB); PG8_STAGE(PG8_SA(0, 0), cA, voffA); PG8_STAGE(PG8_SA(0, 1), cA + hstep, voffA);
        if (wr == 1) PG8_BAR;
        PG8_WAIT_V(2); PG8_BAR;
        PG8_STAGE(PG8_SB(1, 0), cB + kstep, voffB); PG8_STAGE(PG8_SA(1, 0), cA + kstep, voffA); PG8_STAGE(PG8_SB(1, 1), cB + hstep + kstep, voffB);
        PG8_WAIT_V(6); PG8_BAR;
    } else {
        PG8_STAGE(PG8_SB(0, 0), cB, voffB); PG8_STAGE(PG8_SA(0, 0), cA, voffA); PG8_STAGE(PG8_SB(0, 1), cB + hstep, voffB); PG8_STAGE(PG8_SA(0, 1), cA + hstep, voffA);
        if (wr == 1) PG8_BAR;
        PG8_WAIT_V(4); PG8_BAR;
        PG8_STAGE(PG8_SB(1, 0), cB + kstep, voffB); PG8_STAGE(PG8_SA(1, 0), cA + kstep, voffA); PG8_STAGE(PG8_SB(1, 1), cB + hstep + kstep, voffB);
        PG8_WAIT_V(6); PG8_BAR;
    }
    for (;;) {
        const bool has_next = S.next(ui + 1, nxt);
        const char* nA = has_next ? (const char*)g.A + (size_t)nxt.pm * tstep : cA; const char* nB = has_next ? (const char*)g.Bt + (size_t)nxt.pn * tstep : cB;
        for (int t = 0; t < nt; t += 2) {
            const bool last = (t == nt - 2);
            const char* a1 = cA + (size_t)(t + 1) * kstep;
            const char* a2 = last ? nA : cA + (size_t)(t + 2) * kstep; const char* b2 = last ? nB : cB + (size_t)(t + 2) * kstep;
            const char* a3 = a2 + kstep; const char* b3 = b2 + kstep;
            if (last && has_next) S.a_ready(nxt);
            if constexpr (SP2) {
            PG8_LDB(B0, 0, 0); PG8_LDB(B1, 0, 1); PG8_SCHED; PG8_LDA(At, 0, 0); PG8_STAGE(PG8_SA(1, 1), a1 + hstep, voffA);
            PG8_WAIT_V(8); PG8_WAIT_L(0); PG8_BAR; PG8_MMA(0, 0, At, B0); PG8_MMA(0, 1, At, B1); PG8_BAR; PG8_SCHED;
            PG8_LDA(At, 0, 1); PG8_STAGE(PG8_SB(0, 0), b2, voffB); PG8_STAGE(PG8_SB(0, 1), b2 + hstep, voffB); PG8_STAGE(PG8_SA(0, 0), a2, voffA);
            PG8_WAIT_V(8); PG8_WAIT_L(0); PG8_BAR; PG8_MMA(1, 0, At, B0); PG8_MMA(1, 1, At, B1); PG8_BAR; PG8_SCHED;
            PG8_LDB(B0, 1, 0); PG8_LDB(B1, 1, 1); PG8_SCHED; PG8_LDA(At, 1, 0); PG8_STAGE(PG8_SA(0, 1), a2 + hstep, voffA);
            PG8_WAIT_V(8); PG8_WAIT_L(0); PG8_BAR; PG8_MMA(0, 0, At, B0); PG8_MMA(0, 1, At, B1); PG8_BAR; PG8_SCHED;
            PG8_LDA(At, 1, 1); PG8_STAGE(PG8_SB(1, 0), b3, voffB); PG8_STAGE(PG8_SB(1, 1), b3 + hstep, voffB); PG8_STAGE(PG8_SA(1, 0), a3, voffA);
            PG8_WAIT_V(8); PG8_WAIT_L(0); PG8_BAR; PG8_MMA(1, 0, At, B0); PG8_MMA(1, 1, At, B1); PG8_BAR; PG8_SCHED;
            } else {
            PG8_LDB(B0, 0, 0); PG8_SCHED; PG8_LDA(At, 0, 0); PG8_STAGE(PG8_SA(1, 1), a1 + hstep, voffA);
            PG8_WAIT_L(8); PG8_BAR; PG8_WAIT_L(0); PG8_MMA(0, 0, At, B0); PG8_BAR; PG8_SCHED;
            PG8_LDB(B1, 0, 1); PG8_STAGE(PG8_SB(0, 0), b2, voffB);
            PG8_BAR; PG8_WAIT_L(0); PG8_MMA(0, 1, At, B1); PG8_BAR;
            PG8_LDA(At, 0, 1); PG8_STAGE(PG8_SA(0, 0), a2, voffA);
            PG8_BAR; PG8_WAIT_L(0); PG8_MMA(1, 0, At, B0); PG8_BAR; PG8_SCHED;
            PG8_STAGE(PG8_SB(0, 1), b2 + hstep, voffB);
            PG8_WAIT_V(6); PG8_BAR; PG8_MMA(1, 1, At, B1); PG8_BAR;
            PG8_LDB(B0, 1, 0); PG8_SCHED; PG8_LDA(At, 1, 0); PG8_STAGE(PG8_SA(0, 1), a2 + hstep, voffA);
            PG8_WAIT_L(8); PG8_BAR; PG8_WAIT_L(0); PG8_MMA(0, 0, At, B0); PG8_BAR; PG8_SCHED;
            PG8_LDB(B1, 1, 1); PG8_STAGE(PG8_SB(1, 0), b3, voffB);
            PG8_BAR; PG8_WAIT_L(0); PG8_MMA(0, 1, At, B1); PG8_BAR;
            PG8_LDA(At, 1, 1); PG8_STAGE(PG8_SA(1, 0), a3, voffA);
            PG8_BAR; PG8_WAIT_L(0); PG8_MMA(1, 0, At, B0); PG8_BAR; PG8_SCHED;
            PG8_STAGE(PG8_SB(1, 1), b3 + hstep, voffB);
            PG8_WAIT_V(6); PG8_BAR; PG8_MMA(1, 1, At, B1); PG8_BAR;
            }
        }
        if constexpr (ALIGN_EPI) { if (wr == 0) PG8_BAR; }
        if constexpr (!Epi::AFTER_DRAIN) { E(acc, cur, wr, wc, fr, fq); S.done(cur); }
        if (!has_next) break;
#pragma unroll
        for (int a = 0; a < 2; ++a)
#pragma unroll
            for (int b = 0; b < 2; ++b)
#pragma unroll
                for (int m = 0; m < 4; ++m)
#pragma unroll
                    for (int n = 0; n < 2; ++n) acc[a][b][m][n] = (f32x4){0.f, 0.f, 0.f, 0.f};
        cur = nxt; cA = nA; cB = nB; ++ui;
        if constexpr (ALIGN_EPI) { if (wr == 1) PG8_BAR; }
    }
    PG8_WAIT_V(0);
    if constexpr (!ALIGN_EPI) { if (wr == 0) PG8_BAR; }
    PG8_BAR;
    if constexpr (Epi::AFTER_DRAIN) { E.fused(acc, cur, wr, wc, fr, fq, lds, wid, lane); S.done(cur); }
#undef PG8_SA
#undef PG8_SB
#undef PG8_STAGE
#undef PG8_LDA
#undef PG8_LDB
#undef PG8_MMA
#undef PG8_WAIT_V
#undef PG8_WAIT_L
#undef PG8_BAR
#undef PG8_SCHED
}
}

#define LAS __attribute__((address_space(3)))
typedef unsigned short bf16;
typedef short bf16x8 __attribute__((ext_vector_type(8)));
typedef float f32x4 __attribute__((ext_vector_type(4)));
typedef float f32x16 __attribute__((ext_vector_type(16)));
typedef unsigned u32x4 __attribute__((ext_vector_type(4)));
typedef unsigned u32x2 __attribute__((ext_vector_type(2)));
typedef float f32x2_t __attribute__((ext_vector_type(2)));
typedef __bf16 bf16x2_t __attribute__((ext_vector_type(2)));
using pg8::Unit;

constexpr int M = 32768, SEQ = 8192, DM = 1024, FF = 2816, NGU = 5632;
constexpr float EPS = 1e-6f;
constexpr float LOG2E = 1.4426950408889634f;
constexpr size_t MiB = (size_t)1 << 20;
constexpr size_t WS_COSM = 0, WS_SINM = 1 * MiB, WS_COSD = 2 * MiB, WS_SIND = 2 * MiB + 256 * 1024;
constexpr size_t WS_S5A = 2 * MiB + 512 * 1024, WS_S5A64 = WS_S5A + 64 * 1024, WS_S5BB = 3 * MiB, WS_S5CT = 3 * MiB + 512 * 1024, WS_LAM = 4 * MiB;
constexpr size_t WS_W = 8 * MiB, WS_XN = 170 * MiB, WS_R1 = 234 * MiB, WS_NEED = 496 * MiB;
constexpr size_t W_FFN_L = 17301504, W_GU1 = 0, W_D1 = 5767168, W_GU2 = 8650752, W_D2 = 14417920;
constexpr size_t W_EVEN0 = 69206016, W_EVEN_L = 3538944, W_WIN = 0, W_QUP = 1572864, W_KVUP = 1966080, W_GLU = 2228224, W_WOUT = 2490368;
constexpr size_t W_ODD0 = W_EVEN0 + 2 * W_EVEN_L, W_ODD_L = 4194304, W_DIN = 0, W_DOUT = 3145728;
constexpr size_t R_H = 0;
constexpr size_t R_ZA = 0, R_Q = 0, R_KN = 48 * MiB, R_VT = 80 * MiB, R_U = 112 * MiB, R_ZQN = 176 * MiB, R_YGB = 176 * MiB, R_ZKVN = 208 * MiB, R_KPE = 224 * MiB,
                 R_SLOC = 228 * MiB, R_CARRY = 244 * MiB;
constexpr size_t R_QD = 0, R_KD = 64 * MiB, R_VTD = 128 * MiB;
constexpr int ZA_LD = 832, ZN = 1536;

__device__ __forceinline__ unsigned pk2(float lo, float hi) { f32x2_t v = {lo, hi}; bf16x2_t b = __builtin_convertvector(v, bf16x2_t); return __builtin_bit_cast(unsigned, b); }
__device__ __forceinline__ bf16x8 pack8(f32x4 a, f32x4 b) { u32x4 w = {pk2(a[0], a[1]), pk2(a[2], a[3]), pk2(b[0], b[1]), pk2(b[2], b[3])}; return __builtin_bit_cast(bf16x8, w); }
__device__ __forceinline__ float bf2f(unsigned short v) { return __uint_as_float((unsigned)v << 16); }
__device__ __forceinline__ float xor32_max(float v) { auto rr = __builtin_amdgcn_permlane32_swap(__float_as_uint(v), __float_as_uint(v), false, false); return fmaxf(__uint_as_float(rr[0]), __uint_as_float(rr[1])); }
__device__ __forceinline__ float xor32_add(float v) { auto rr = __builtin_amdgcn_permlane32_swap(__float_as_uint(v), __float_as_uint(v), false, false); return __uint_as_float(rr[0]) + __uint_as_float(rr[1]); }
#define SWZ_XOR(v, m) __int_as_float(__builtin_amdgcn_ds_swizzle(__float_as_int(v), 0x1f | ((m) << 10)))
__device__ __forceinline__ float wave_sum(float v) {
    v += SWZ_XOR(v, 1); v += SWZ_XOR(v, 2); v += SWZ_XOR(v, 4); v += SWZ_XOR(v, 8); v += SWZ_XOR(v, 16);
    return xor32_add(v);
}
__device__ __forceinline__ float sigmoidf_(float v) { return __builtin_amdgcn_rcpf(1.0f + __builtin_amdgcn_exp2f(v * -1.4426950408889634f)); }
#define MFMA32(a, b, c) __builtin_amdgcn_mfma_f32_32x32x16_bf16((a), (b), (c), 0, 0, 0)
#define MFMA16(a, b, c) __builtin_amdgcn_mfma_f32_16x16x32_bf16((a), (b), (c), 0, 0, 0)

#define EPI_LOOP_BEGIN \
    _Pragma("unroll") for (int ai = 0; ai < 2; ++ai) _Pragma("unroll") for (int m = 0; m < 4; ++m) _Pragma("unroll") for (int bj = 0; bj < 2; ++bj) { \
        const int row = u.pm * 256 + ai * 128 + wr * 64 + m * 16 + fr; const int col0 = u.pn * 256 + bj * 128 + wc * 32 + 8 * fq; \
        const f32x4 v0 = acc[ai][bj][m][0], v1 = acc[ai][bj][m][1]; (void)row; (void)col0;
#define EPI_LOOP_END }

struct EpiSwiglu {
    static constexpr bool PERM = true, AFTER_DRAIN = false;
    bf16* H;
    __device__ __forceinline__ void operator()(const f32x4 (&acc)[2][2][4][2], const Unit& u, int wr, int wc, int fr, int fq) const {
#pragma unroll
        for (int ai = 0; ai < 2; ++ai)
#pragma unroll
            for (int m = 0; m < 4; ++m) {
                const int row = u.pm * 256 + ai * 128 + wr * 64 + m * 16 + fr, f0 = u.pn * 128 + wc * 32 + 8 * fq;
                const f32x4 g0 = acc[ai][0][m][0], g1 = acc[ai][0][m][1], u0 = acc[ai][1][m][0], u1 = acc[ai][1][m][1];
                f32x4 o0, o1;
#pragma unroll
                for (int e = 0; e < 4; ++e) { o0[e] = g0[e] * sigmoidf_(g0[e]) * u0[e]; o1[e] = g1[e] * sigmoidf_(g1[e]) * u1[e]; }
                *(bf16x8*)(H + (size_t)row * FF + f0) = pack8(o0, o1);
            }
    }
};
struct EpiResid {
    static constexpr bool PERM = true, AFTER_DRAIN = false;
    const float* src; float* dst;
    __device__ __forceinline__ void operator()(const f32x4 (&acc)[2][2][4][2], const Unit& u, int wr, int wc, int fr, int fq) const {
        EPI_LOOP_BEGIN
            const size_t off = (size_t)row * DM + col0;
            const f32x4 a = *(const f32x4*)(src + off), b = *(const f32x4*)(src + off + 4);
            *(f32x4*)(dst + off) = a + v0; *(f32x4*)(dst + off + 4) = b + v1;
        EPI_LOOP_END
    }
};
struct EpiZ {
    static constexpr bool PERM = true, AFTER_DRAIN = false;
    float* ZA; float* U;
    __device__ __forceinline__ void operator()(const f32x4 (&acc)[2][2][4][2], const Unit& u, int wr, int wc, int fr, int fq) const {
        EPI_LOOP_BEGIN
            if (col0 < 832) { float* p = ZA + (size_t)row * ZA_LD + col0; *(f32x4*)p = v0; *(f32x4*)(p + 4) = v1; }
            else if (col0 < 1344) { float* p = U + (size_t)row * 512 + (col0 - 832); *(f32x4*)p = v0; *(f32x4*)(p + 4) = v1; }
        EPI_LOOP_END
    }
};
struct EpiQ {
    static constexpr bool PERM = true, AFTER_DRAIN = false;
    bf16* Q; const float* cosm; const float* sinm; float qs;
    __device__ __forceinline__ void operator()(const f32x4 (&acc)[2][2][4][2], const Unit& u, int wr, int wc, int fr, int fq) const {
        EPI_LOOP_BEGIN
            f32x4 a = v0, b = v1;
            const int hq = col0 / 192, d = col0 - hq * 192;
            if (d >= 128) {
                const int t0 = (d - 128) >> 1; const int pos = row & (SEQ - 1);
                const f32x4 c = *(const f32x4*)(cosm + pos * 32 + t0), s = *(const f32x4*)(sinm + pos * 32 + t0);
                a = (f32x4){v0[0] * c[0] - v0[1] * s[0], v0[1] * c[0] + v0[0] * s[0], v0[2] * c[1] - v0[3] * s[1], v0[3] * c[1] + v0[2] * s[1]};
                b = (f32x4){v1[0] * c[2] - v1[1] * s[2], v1[1] * c[2] + v1[0] * s[2], v1[2] * c[3] - v1[3] * s[3], v1[3] * c[3] + v1[2] * s[3]};
            }
            a = a * qs; b = b * qs;
            *(bf16x8*)(Q + (size_t)row * 768 + col0) = pack8(a, b);
        EPI_LOOP_END
    }
};
struct EpiKV {
    static constexpr bool PERM = true, AFTER_DRAIN = false;
    bf16* KN; bf16* VT;
    __device__ __forceinline__ void operator()(const f32x4 (&acc)[2][2][4][2], const Unit& u, int wr, int wc, int fr, int fq) const {
        EPI_LOOP_BEGIN
            const int hq = u.pn, dl = wc * 32 + 8 * fq;
            if (bj == 0) { *(bf16x8*)(KN + (size_t)row * 512 + hq * 128 + dl) = pack8(v0, v1); }
            else {
                const int b = row >> 13, s0_ = row & (SEQ - 1), s = (s0_ & ~15) | (((s0_ >> 2) & 1) << 3) | (((s0_ >> 3) & 1) << 2) | (s0_ & 3);
                bf16* p = VT + ((size_t)((b * 4 + hq) * 128 + dl)) * SEQ + s;
                const bf16x8 w = pack8(v0, v1);
#pragma unroll
                for (int e = 0; e < 8; ++e) p[(size_t)e * SEQ] = (bf16)w[e];
            }
        EPI_LOOP_END
    }
};
struct EpiDiffIn {
    static constexpr bool PERM = true, AFTER_DRAIN = false;
    bf16* QD; bf16* KD; bf16* VT; const float* cosd; const float* sind; float qs;
    __device__ __forceinline__ void operator()(const f32x4 (&acc)[2][2][4][2], const Unit& u, int wr, int wc, int fr, int fq) const {
        EPI_LOOP_BEGIN
            if (col0 < 2048) {
                f32x4 a = v0, b = v1;
                const int d = col0 & 63;
                if (d < 16) {
                    const int t0 = d >> 1; const int pos = row & (SEQ - 1);
                    const f32x4 c = *(const f32x4*)(cosd + pos * 8 + t0), s = *(const f32x4*)(sind + pos * 8 + t0);
                    a = (f32x4){v0[0] * c[0] - v0[1] * s[0], v0[1] * c[0] + v0[0] * s[0], v0[2] * c[1] - v0[3] * s[1], v0[3] * c[1] + v0[2] * s[1]};
                    b = (f32x4){v1[0] * c[2] - v1[1] * s[2], v1[1] * c[2] + v1[0] * s[2], v1[2] * c[3] - v1[3] * s[3], v1[3] * c[3] + v1[2] * s[3]};
                }
                if (col0 < 1024) { a = a * qs; b = b * qs; *(bf16x8*)(QD + (size_t)row * 1024 + col0) = pack8(a, b); }
                else { *(bf16x8*)(KD + (size_t)row * 1024 + (col0 - 1024)) = pack8(a, b); }
            } else {
                const int hv = (col0 - 2048) >> 7, dl = col0 & 127;
                const int b = row >> 13, s0_ = row & (SEQ - 1), s = (s0_ & ~15) | (((s0_ >> 2) & 1) << 3) | (((s0_ >> 3) & 1) << 2) | (s0_ & 3);
                bf16* p = VT + ((size_t)((b * 8 + hv) * 128 + dl)) * SEQ + s;
                const bf16x8 w = pack8(v0, v1);
#pragma unroll
                for (int e = 0; e < 8; ++e) p[(size_t)e * SEQ] = (bf16)w[e];
            }
        EPI_LOOP_END
    }
};
struct EpiGlu {
    static constexpr bool PERM = true, AFTER_DRAIN = false;
    const bf16* YG; const float* bias; bf16* CAT;
    __device__ __forceinline__ void operator()(const f32x4 (&acc)[2][2][4][2], const Unit& u, int wr, int wc, int fr, int fq) const {
        EPI_LOOP_BEGIN
            const f32x4 b0 = *(const f32x4*)(bias + col0), b1 = *(const f32x4*)(bias + col0 + 4);
            const bf16x8 y = *(const bf16x8*)(YG + (size_t)row * 512 + col0);
            f32x4 o0, o1;
#pragma unroll
            for (int e = 0; e < 4; ++e) { o0[e] = bf2f((unsigned short)y[e]) * sigmoidf_(v0[e] + b0[e]); o1[e] = bf2f((unsigned short)y[4 + e]) * sigmoidf_(v1[e] + b1[e]); }
            *(bf16x8*)(CAT + (size_t)row * DM + 512 + col0) = pack8(o0, o1);
        EPI_LOOP_END
    }
};

__device__ __forceinline__ void prep_w(const float* W, int K, int N, bf16* dst, int mode, int omul, int oadd, const float* gain, int gmask, float scale, int gw, int NGW, int lane, LAS float* scr) {
    const int nkb = K >> 6, nnb = N >> 5, nitems = nkb * nnb;
    const int hl = lane >> 5, l31 = lane & 31, c = lane & 7, r8 = lane >> 3;
    for (int it = gw; it < nitems; it += NGW) {
        const int kb = it / nnb, nb = it - kb * nnb, k0 = kb * 64, n0 = nb * 32;
        const float* src = W + (size_t)(k0 + hl) * N + n0 + l31;
        float v[32];
#pragma unroll
        for (int i = 0; i < 32; ++i) v[i] = src[(size_t)(2 * i) * N];
#pragma unroll
        for (int i = 0; i < 32; ++i) { const int k = k0 + 2 * i + hl; const float g = gain ? gain[k & gmask] * scale : scale; scr[(2 * i + hl) * 33 + l31] = v[i] * g; }
        asm volatile("s_waitcnt lgkmcnt(0)" ::: "memory");
#pragma unroll
        for (int j = 0; j < 4; ++j) {
            const int nl = r8 + 8 * j, n = n0 + nl;
            int nd = n;
            if (mode == 2) { const int hq = n / 192; int d = n - hq * 192; if (d >= 128) { const int dd = d - 128; d = 128 + 2 * (dd & 31) + (dd >> 5); } nd = hq * 192 + d; }
            else if (mode == 3) { if (n < 2048) { int d = n & 63; if (d < 16) d = 2 * (d & 7) + (d >> 3); nd = (n & ~63) + d; } }
            if (mode == 4) nd = (n >> 7) * 256 + (n & 127) + oadd; else nd = nd * omul + oadd;
            const LAS float* sp = scr + (8 * c) * 33 + nl;
            const f32x4 a = {sp[0], sp[33], sp[66], sp[99]}, b = {sp[132], sp[165], sp[198], sp[231]};
            *(bf16x8*)(dst + (size_t)nd * K + k0 + 8 * c) = pack8(a, b);
        }
        asm volatile("s_waitcnt lgkmcnt(0)" ::: "memory");
    }
}

__device__ __forceinline__ void norm_rows(const float* x, bf16* xn, int gw, int NGW, int lane) {
    for (int row = gw; row < M; row += 2 * NGW) {
        const int row2 = row + NGW; const bool has2 = row2 < M;
        const f32x4* xr = (const f32x4*)(x + (size_t)row * DM) + lane;
        const f32x4* xr2 = (const f32x4*)(x + (size_t)(has2 ? row2 : row) * DM) + lane;
        f32x4 v[4], w[4]; float s = 0.f, s2 = 0.f;
#pragma unroll
        for (int j = 0; j < 4; ++j) { v[j] = xr[64 * j]; w[j] = xr2[64 * j]; }
#pragma unroll
        for (int j = 0; j < 4; ++j) { s += (v[j][0] * v[j][0] + v[j][1] * v[j][1]) + (v[j][2] * v[j][2] + v[j][3] * v[j][3]); s2 += (w[j][0] * w[j][0] + w[j][1] * w[j][1]) + (w[j][2] * w[j][2] + w[j][3] * w[j][3]); }
        const float rstd = rsqrtf(wave_sum(s) * (1.f / DM) + EPS), rstd2 = rsqrtf(wave_sum(s2) * (1.f / DM) + EPS);
        u32x2* o = (u32x2*)(xn + (size_t)row * DM) + lane;
#pragma unroll
        for (int j = 0; j < 4; ++j) o[64 * j] = (u32x2){pk2(v[j][0] * rstd, v[j][1] * rstd), pk2(v[j][2] * rstd, v[j][3] * rstd)};
        if (has2) {
            u32x2* o2 = (u32x2*)(xn + (size_t)row2 * DM) + lane;
#pragma unroll
            for (int j = 0; j < 4; ++j) o2[64 * j] = (u32x2){pk2(w[j][0] * rstd2, w[j][1] * rstd2), pk2(w[j][2] * rstd2, w[j][3] * rstd2)};
        }
    }
}
__device__ __forceinline__ void final_norm_rows(float* x, const float* gain, int gw, int NGW, int lane) {
    for (int row = gw; row < M; row += 2 * NGW) {
        const int row2 = (row + NGW < M) ? row + NGW : row;
        f32x4* xr = (f32x4*)(x + (size_t)row * DM) + lane; f32x4* xr2 = (f32x4*)(x + (size_t)row2 * DM) + lane;
        f32x4 v[4], w[4]; float s = 0.f, s2 = 0.f;
#pragma unroll
        for (int j = 0; j < 4; ++j) { v[j] = xr[64 * j]; w[j] = xr2[64 * j]; }
#pragma unroll
        for (int j = 0; j < 4; ++j) { s += (v[j][0] * v[j][0] + v[j][1] * v[j][1]) + (v[j][2] * v[j][2] + v[j][3] * v[j][3]); s2 += (w[j][0] * w[j][0] + w[j][1] * w[j][1]) + (w[j][2] * w[j][2] + w[j][3] * w[j][3]); }
        const float rstd = rsqrtf(wave_sum(s) * (1.f / DM) + EPS), rstd2 = rsqrtf(wave_sum(s2) * (1.f / DM) + EPS);
#pragma unroll
        for (int j = 0; j < 4; ++j) { const f32x4 g = ((const f32x4*)gain)[lane + 64 * j]; xr[64 * j] = v[j] * rstd * g; if (row2 != row) xr2[64 * j] = w[j] * rstd2 * g; }
    }
}
__device__ __forceinline__ void post_rows(const float* ZA, bf16* ZQN, bf16* ZKVN, bf16* KPE, const float* cosm, const float* sinm, int gw, int NGW, int lane) {
    for (int row = gw; row < M; row += NGW) {
        const float* za = ZA + (size_t)row * ZA_LD;
        const f32x4 a0 = ((const f32x4*)za)[lane], a1 = ((const f32x4*)za)[64 + lane], kv = ((const f32x4*)(za + 512))[lane];
        float sq = (a0[0] * a0[0] + a0[1] * a0[1]) + (a0[2] * a0[2] + a0[3] * a0[3]) + (a1[0] * a1[0] + a1[1] * a1[1]) + (a1[2] * a1[2] + a1[3] * a1[3]);
        float sk = (kv[0] * kv[0] + kv[1] * kv[1]) + (kv[2] * kv[2] + kv[3] * kv[3]);
        const float rq = rsqrtf(wave_sum(sq) * (1.f / 512.f) + EPS), rk = rsqrtf(wave_sum(sk) * (1.f / 256.f) + EPS);
        u32x2* oq = (u32x2*)(ZQN + (size_t)row * 512);
        oq[lane] = (u32x2){pk2(a0[0] * rq, a0[1] * rq), pk2(a0[2] * rq, a0[3] * rq)};
        oq[64 + lane] = (u32x2){pk2(a1[0] * rq, a1[1] * rq), pk2(a1[2] * rq, a1[3] * rq)};
        ((u32x2*)(ZKVN + (size_t)row * 256))[lane] = (u32x2){pk2(kv[0] * rk, kv[1] * rk), pk2(kv[2] * rk, kv[3] * rk)};
        if (lane < 32) {
            const float x1 = za[768 + lane], x2 = za[800 + lane]; const int pos = row & (SEQ - 1);
            const float c = cosm[pos * 32 + lane], s = sinm[pos * 32 + lane];
            ((unsigned*)(KPE + (size_t)row * 64))[lane] = pk2(x1 * c - x2 * s, x2 * c + x1 * s);
        }
    }
}

template <bool PC>
__device__ __forceinline__ void s5_pass(LAS unsigned char* xl  , const float* U, const float2* Atab, const bf16* BB, const bf16* CT,
                                        float2* SLOC, const float2* CARRY, const float* dvec, bf16* YGb, int gw, int NGW, int lane) {
    const int col = lane & 31, hi = lane >> 5;
    const int aseq = (col >> 2) & 1, ai_ = (col & 3) + 4 * (col >> 3);
    const int c16 = lane & 15, quad = lane >> 4;
    for (int u = gw; u < 8192; u += NGW) {
        const int g = u & 31, bp = (u >> 5) & 1, ch = u >> 6;
        const int b0 = bp * 2, t0 = ch * 64;
        bf16x8 ua[4];
#pragma unroll
        for (int blk = 0; blk < 4; ++blk) {
            const float* p = U + ((size_t)((b0 + aseq) * SEQ + t0 + 16 * blk + ai_)) * 512 + g * 16 + 8 * hi;
            ua[blk] = pack8(*(const f32x4*)p, *(const f32x4*)(p + 4));
        }
        f32x4 acc[2][4];
#pragma unroll
        for (int s = 0; s < 2; ++s)
#pragma unroll
            for (int b = 0; b < 4; ++b) acc[s][b] = (f32x4){0.f, 0.f, 0.f, 0.f};
#pragma unroll
        for (int dir = 0; dir < 2; ++dir) {
            const int tb = dir * 32 + g;
            bf16x8 bbf[4];
#pragma unroll
            for (int q = 0; q < 4; ++q) bbf[q] = *(const bf16x8*)(BB + ((size_t)tb * 128 + q * 32 + col) * 16 + 8 * hi);
            const float2 a0 = Atab[tb * 64 + col], a1 = Atab[tb * 64 + col + 32];
            const size_t sidx = ((size_t)((dir * 4 + b0 + hi) * 32 + g) * 128 + ch) * 64;
            float xr0 = 0.f, xi0 = 0.f, xr1 = 0.f, xi1 = 0.f;
            bf16x8 ctf[4];
            if (PC) {
                const float2 c0 = CARRY[sidx + col], c1 = CARRY[sidx + col + 32];
                xr0 = c0.x; xi0 = c0.y; xr1 = c1.x; xi1 = c1.y;
#pragma unroll
                for (int kq = 0; kq < 4; ++kq) ctf[kq] = *(const bf16x8*)(CT + ((size_t)tb * 16 + c16) * 128 + 32 * kq + 8 * quad);
            }
#pragma unroll
            for (int bb = 0; bb < 4; ++bb) {
                const int blk = dir ? 3 - bb : bb;
                f32x16 bu[4];
                const f32x16 zero = {0.f, 0.f, 0.f, 0.f, 0.f, 0.f, 0.f, 0.f, 0.f, 0.f, 0.f, 0.f, 0.f, 0.f, 0.f, 0.f};
#pragma unroll
                for (int q = 0; q < 4; ++q) bu[q] = MFMA32(ua[blk], bbf[q], zero);
#pragma unroll
                for (int ii = 0; ii < 16; ++ii) {
                    const int i = dir ? 15 - ii : ii;
                    const float nr0 = a0.x * xr0 - a0.y * xi0 + bu[0][i], ni0 = a0.x * xi0 + a0.y * xr0 + bu[1][i];
                    const float nr1 = a1.x * xr1 - a1.y * xi1 + bu[2][i], ni1 = a1.x * xi1 + a1.y * xr1 + bu[3][i];
                    xr0 = nr0; xi0 = ni0; xr1 = nr1; xi1 = ni1;
                    if (PC) *(LAS u32x2*)(xl + (16 * hi + i) * 272 + col * 8) = (u32x2){pk2(xr0, xi0), pk2(xr1, xi1)};
                }
                if (PC) {
#pragma unroll
                    for (int s = 0; s < 2; ++s)
#pragma unroll
                        for (int kq = 0; kq < 4; ++kq) {
                            const bf16x8 xa = *(const LAS bf16x8*)(xl + (16 * s + c16) * 272 + (32 * kq + 8 * quad) * 2);
                            acc[s][blk] = MFMA16(xa, ctf[kq], acc[s][blk]);
                        }
                }
            }
            if (!PC) { SLOC[sidx + col] = make_float2(xr0, xi0); SLOC[sidx + col + 32] = make_float2(xr1, xi1); }
        }
        if (PC) {
            const int cc = g * 16 + c16; const float dv = dvec[cc];
#pragma unroll
            for (int s = 0; s < 2; ++s)
#pragma unroll
                for (int blk = 0; blk < 4; ++blk)
#pragma unroll
                    for (int j = 0; j < 4; ++j) {
                        const size_t row = (size_t)(b0 + s) * SEQ + t0 + 16 * blk + 4 * quad + j;
                        float y = acc[s][blk][j] + dv * U[row * 512 + cc];
                        const float z2 = 1.5957691216f * (y + 0.044715f * y * y * y);
                        y = y * __builtin_amdgcn_rcpf(1.0f + __builtin_amdgcn_exp2f(z2 * -1.4426950408889634f));
                        YGb[row * 512 + cc] = (bf16)(pk2(y, 0.f) & 0xffffu);
                    }
        }
    }
}
__device__ __forceinline__ void s5_passB(const float2* A64, const float2* SLOC, float2* CARRY) {
    int tid_ = threadIdx.x; asm volatile("" : "+v"(tid_));
    if (tid_ >= 64) return;
    for (int idx = blockIdx.x * 64 + tid_; idx < 16384; idx += gridDim.x * 64) {
        const int dir = idx >> 13, rest = idx & 8191, b = rest >> 11, g = (rest >> 6) & 31, p = rest & 63;
        const float2 a = A64[(dir * 32 + g) * 64 + p];
        const size_t base = ((size_t)((dir * 4 + b) * 32 + g) * 128) * 64 + p;
        float cr = 0.f, ci = 0.f;
#pragma unroll 1
        for (int kk0 = 0; kk0 < 128; kk0 += 32) {
            float2 sv[32];
#pragma unroll
            for (int j = 0; j < 32; ++j) { const int k = dir ? 127 - (kk0 + j) : kk0 + j; sv[j] = SLOC[base + (size_t)k * 64]; }
#pragma unroll
            for (int j = 0; j < 32; ++j) {
                const int k = dir ? 127 - (kk0 + j) : kk0 + j;
                CARRY[base + (size_t)k * 64] = make_float2(cr, ci);
                const float nr = a.x * cr - a.y * ci + sv[j].x, ni = a.x * ci + a.y * cr + sv[j].y;
                cr = nr; ci = ni;
            }
        }
    }
}

__device__ __forceinline__ void glds16(const void* gsrc, unsigned lds_dst) {
    unsigned keep;
    asm volatile("s_mov_b32 %0, m0\n\ts_mov_b32 m0, %2\n\ts_nop 0\n\tglobal_load_lds_dwordx4 %1, off\n\ts_mov_b32 m0, %0" : "=&s"(keep) : "v"(gsrc), "s"(lds_dst) : "memory");
}
__device__ __forceinline__ void glds16x2(const void* g0, const void* g1, unsigned lds_dst) {
    unsigned keep;
    asm volatile("s_mov_b32 %0, m0\n\ts_mov_b32 m0, %3\n\ts_nop 0\n\tglobal_load_lds_dwordx4 %1, off\n\ts_add_u32 m0, m0, 0x2000\n\ts_nop 0\n\tglobal_load_lds_dwordx4 %2, off\n\ts_mov_b32 m0, %0"
                 : "=&s"(keep) : "v"(g0), "v"(g1), "s"(lds_dst) : "memory", "scc");
}
__device__ __forceinline__ void glds16x3(const void* g0, const void* g1, const void* g2, unsigned lds_dst) {
    unsigned keep;
    asm volatile("s_mov_b32 %0, m0\n\ts_mov_b32 m0, %4\n\ts_nop 0\n\tglobal_load_lds_dwordx4 %1, off\n\ts_add_u32 m0, m0, 0x2000\n\ts_nop 0\n\tglobal_load_lds_dwordx4 %2, off\n\ts_add_u32 m0, m0, 0x2000\n\ts_nop 0\n\tglobal_load_lds_dwordx4 %3, off\n\ts_mov_b32 m0, %0"
                 : "=&s"(keep) : "v"(g0), "v"(g1), "v"(g2), "s"(lds_dst) : "memory", "scc");
}
template <int MODE>
__device__ __forceinline__ void att_qk(f32x16& s0, f32x16& s1, const LAS unsigned char* kslot, int ka, const bf16x8 (&qf)[MODE == 0 ? 12 : 4]) {
    constexpr int NKS = MODE == 0 ? 12 : 4, RB = MODE == 0 ? 384 : 256;
    f32x16 z;
#pragma unroll
    for (int i = 0; i < 16; ++i) z[i] = 0.f;
#pragma unroll
    for (int ks = 0; ks < NKS; ++ks) {
        const LAS unsigned char* p = kslot + ((ka ^ ((ks & 3) * 32)) + (ks >> 2) * 128);
        const bf16x8 a0 = *(const LAS bf16x8*)p, a1 = *(const LAS bf16x8*)(p + 32 * RB);
        if (ks == 0) { s0 = MFMA32(a0, qf[0], z); s1 = MFMA32(a1, qf[0], z); }
        else { s0 = MFMA32(a0, qf[ks], s0); s1 = MFMA32(a1, qf[ks], s1); }
    }
}
__device__ __forceinline__ float att_rowmax(const f32x16& s0, const f32x16& s1) {
    float a = fmaxf(fmaxf(s0[0], s0[1]), s1[0]), b = fmaxf(fmaxf(s0[2], s0[3]), s1[1]);
    a = fmaxf(fmaxf(a, s1[2]), s1[3]);
#pragma unroll
    for (int i = 4; i < 16; i += 4) { a = fmaxf(fmaxf(a, s0[i]), s0[i + 1]); b = fmaxf(fmaxf(b, s0[i + 2]), s0[i + 3]); a = fmaxf(fmaxf(a, s1[i]), s1[i + 1]); b = fmaxf(fmaxf(b, s1[i + 2]), s1[i + 3]); }
    return xor32_max(fmaxf(a, b));
}
__device__ __forceinline__ void att_exp(f32x16& s0, f32x16& s1, float mhat, float& lrun, bf16x8 (&pf)[4]) {
    float p0 = 0.f, p1 = 0.f;
#pragma unroll
    for (int i = 0; i < 16; ++i) { s0[i] = __builtin_amdgcn_exp2f(s0[i] - mhat); s1[i] = __builtin_amdgcn_exp2f(s1[i] - mhat); p0 += s0[i]; p1 += s1[i]; }
    lrun += p0 + p1;
    pf[0] = pack8((f32x4){s0[0], s0[1], s0[2], s0[3]}, (f32x4){s0[4], s0[5], s0[6], s0[7]});
    pf[1] = pack8((f32x4){s0[8], s0[9], s0[10], s0[11]}, (f32x4){s0[12], s0[13], s0[14], s0[15]});
    pf[2] = pack8((f32x4){s1[0], s1[1], s1[2], s1[3]}, (f32x4){s1[4], s1[5], s1[6], s1[7]});
    pf[3] = pack8((f32x4){s1[8], s1[9], s1[10], s1[11]}, (f32x4){s1[12], s1[13], s1[14], s1[15]});
}
__device__ __forceinline__ void att_pv(f32x16 (&o)[4], const LAS unsigned char* vslot, int va, const bf16x8 (&pf)[4]) {
#pragma unroll
    for (int db = 0; db < 4; ++db)
#pragma unroll
        for (int kk = 0; kk < 4; ++kk) {
            const bf16x8 v = *(const LAS bf16x8*)(vslot + ((va ^ (kk * 32)) + db * 4096));
            o[db] = MFMA32(v, pf[kk], o[db]);
        }
}

__device__ __forceinline__ void att1_load(bf16x8 (&kf)[8], bf16x8 (&vf)[8], const LAS unsigned char* kslot, int ka, const LAS unsigned char* vslot, int va) {
#pragma unroll
    for (int ks = 0; ks < 4; ++ks) { const LAS unsigned char* p = kslot + (ka ^ (ks * 32)); kf[2 * ks] = *(const LAS bf16x8*)p; kf[2 * ks + 1] = *(const LAS bf16x8*)(p + 32 * 256); }
#pragma unroll
    for (int kk = 0; kk < 2; ++kk)
#pragma unroll
        for (int db = 0; db < 4; ++db) vf[kk * 4 + db] = *(const LAS bf16x8*)(vslot + ((va ^ (kk * 32)) + db * 4096));
}
__device__ __forceinline__ void att1_load2(bf16x8 (&vg)[8], const LAS unsigned char* vslot, int va) {
#pragma unroll
    for (int kk = 2; kk < 4; ++kk)
#pragma unroll
        for (int db = 0; db < 4; ++db) vg[(kk - 2) * 4 + db] = *(const LAS bf16x8*)(vslot + ((va ^ (kk * 32)) + db * 4096));
}
__device__ __forceinline__ void att1_qk(f32x16& s0, f32x16& s1, const bf16x8 (&kf)[8], const bf16x8 (&qf)[4]) {
    f32x16 z;
#pragma unroll
    for (int i = 0; i < 16; ++i) z[i] = 0.f;
    s0 = MFMA32(kf[0], qf[0], z); s1 = MFMA32(kf[1], qf[0], z);
#pragma unroll
    for (int ks = 1; ks < 4; ++ks) { s0 = MFMA32(kf[2 * ks], qf[ks], s0); s1 = MFMA32(kf[2 * ks + 1], qf[ks], s1); }
}
__device__ __forceinline__ void att1_pv(f32x16 (&o)[4], const bf16x8 (&vf)[8], const bf16x8 (&vg)[8], const bf16x8 (&pf)[4]) {
#pragma unroll
    for (int kk = 0; kk < 2; ++kk)
#pragma unroll
        for (int db = 0; db < 4; ++db) o[db] = MFMA32(vf[kk * 4 + db], pf[kk], o[db]);
#pragma unroll
    for (int kk = 2; kk < 4; ++kk)
#pragma unroll
        for (int db = 0; db < 4; ++db) o[db] = MFMA32(vg[(kk - 2) * 4 + db], pf[kk], o[db]);
}
template <int MODE>
__device__ __forceinline__ void attn_phase(LAS unsigned char* lds, const bf16* Qp, const bf16* Kp, const bf16* KPEp, const bf16* Vtp, bf16* CAT, float lam, int vcu, int G) {
    constexpr int NKS = MODE == 0 ? 12 : 4;
    constexpr int RB = MODE == 0 ? 384 : 256;
    constexpr int KB = 64 * RB, VB = 128 * 128;
    constexpr int NKI = MODE == 0 ? 3 : 2;
    constexpr int NUNITS = MODE == 0 ? 512 : 2048;
    constexpr float THR = 8.f;
    const unsigned lds0 = (unsigned)(uintptr_t)lds;
    for (int unit = vcu; unit < NUNITS; unit += G) {
        int tid_ = threadIdx.x; asm volatile("" : "+v"(tid_)); const int tid = tid_, lane = tid & 63, wave = __builtin_amdgcn_readfirstlane(tid >> 6), r = lane & 31, hh = lane >> 5;
        int b, h, q0, wq, map, bh;
        if (MODE == 0) { const int qb = unit & 31; bh = unit >> 5; b = bh >> 2; h = bh & 3; q0 = qb * 256; wq = wave; map = 0; }
        else { const int qb = unit & 63; bh = unit >> 6; b = bh >> 3; h = bh & 7; q0 = qb * 128; wq = wave & 3; map = wave >> 2; }
        const size_t rowbase = (size_t)b * SEQ;
        const size_t qrow = rowbase + q0 + 32 * wq + r;
        bf16x8 qf[NKS];
        {
            const bf16* qp = MODE == 0 ? Qp + qrow * 768 + h * 192 + 8 * hh : Qp + qrow * 1024 + (2 * h + map) * 64 + 8 * hh;
#pragma unroll
            for (int ks = 0; ks < NKS; ++ks) qf[ks] = *(const bf16x8*)(qp + 16 * ks);
        }
        const bf16* kp[NKI]; int kadv[NKI];
#pragma unroll
        for (int n = 0; n < NKI; ++n) {
            const int P = 64 * (wave + 8 * n) + lane;
            if (MODE == 0) {
                const int row = P / 24, cp = P - row * 24, c = (cp & ~7) | ((cp & 7) ^ ((row >> 1) & 7));
                if (c < 16) { kp[n] = Kp + (rowbase + row) * 512 + h * 128 + c * 8; kadv[n] = 64 * 512; }
                else { kp[n] = KPEp + (rowbase + row) * 64 + (c - 16) * 8; kadv[n] = 64 * 64; }
            } else {
                const int row = P >> 4, c = (P & 15) ^ (row & 15);
                kp[n] = Kp + (rowbase + row) * 1024 + h * 128 + c * 8; kadv[n] = 64 * 1024;
            }
        }
        const bf16* vp[2];
#pragma unroll
        for (int n = 0; n < 2; ++n) { const int P = 64 * (wave + 8 * n) + lane, dv = P >> 3, c = (P & 7) ^ ((dv >> 1) & 7); vp[n] = Vtp + ((size_t)(bh * 128 + dv)) * SEQ + c * 8; }
        const unsigned kdma = lds0 + wave * 1024, vdma = lds0 + 3 * KB + wave * 1024;
#define ATT_DMA_K(slotoff) do { if constexpr (NKI == 3) glds16x3(kp[0], kp[1], kp[NKI - 1], (unsigned)__builtin_amdgcn_readfirstlane(kdma + (slotoff))); else glds16x2(kp[0], kp[1], (unsigned)__builtin_amdgcn_readfirstlane(kdma + (slotoff))); } while (0)
#define ATT_DMA_V(slotoff) do { glds16x2(vp[0], vp[1], (unsigned)__builtin_amdgcn_readfirstlane(vdma + (slotoff))); } while (0)
#define ATT_ADV_K() do { _Pragma("unroll") for (int n = 0; n < NKI; ++n) kp[n] += kadv[n]; } while (0)
#define ATT_ADV_V() do { _Pragma("unroll") for (int n = 0; n < 2; ++n) vp[n] += 64; } while (0)
#define ATT_RESC_O() do { if (havepend) { _Pragma("unroll") for (int db = 0; db < 4; ++db) _Pragma("unroll") for (int i = 0; i < 16; ++i) o[db][i] *= fpend; havepend = false; } } while (0)
        const int ka = MODE == 0 ? r * RB + ((hh ^ ((r >> 1) & 7)) * 16) : r * RB + (((map * 8 + hh) ^ (r & 15)) * 16);
        const int va = r * 128 + ((hh ^ ((r >> 1) & 7)) * 16);
        const LAS unsigned char* vring = lds + 3 * KB;
        f32x16 o[4], S0, S1;
        bf16x8 pf[4];
#pragma unroll
        for (int db = 0; db < 4; ++db)
#pragma unroll
            for (int i = 0; i < 16; ++i) o[db][i] = 0.f;
        float mhat = 0.f, lrun = 0.f, fpend = 1.f; bool havepend = false;
        ATT_DMA_K(0); ATT_ADV_K(); ATT_DMA_K(KB); ATT_ADV_K(); ATT_DMA_V(0); ATT_ADV_V();
        asm volatile("s_waitcnt vmcnt(0) lgkmcnt(0)\n\ts_barrier" ::: "memory");
        int kr = 0, kw = 2 * KB, vr = 2 * VB, vw = VB;
        if constexpr (MODE == 1) {
            bf16x8 pfB[4];
            bf16x8 kf[8], vf[8], vg[8];
            float fp = 1.f; bool pend = false;
#define ATT1_ITER(PFP, PFN, I, DO_C) do { \
            const int i_ = (I); \
            att1_load(kf, vf, lds + kr, ka, vring + vr, va); \
            __builtin_amdgcn_sched_barrier(0); \
            att1_qk(S0, S1, kf, qf); \
            att1_load2(vg, vring + vr, va); \
            const float rm = att_rowmax(S0, S1); \
            if (!(DO_C)) mhat = rm; \
            else if (__any(rm - mhat > THR)) { const float dl = fmaxf(rm - mhat, 0.f); fp = __builtin_amdgcn_exp2f(-dl); lrun *= fp; mhat += dl; pend = true; } \
            if (DO_C) att1_pv(o, vf, vg, PFP); \
            att_exp(S0, S1, mhat, lrun, PFN); \
            if (DO_C) { _Pragma("unroll") for (int g_ = 0; g_ < 16; ++g_) { __builtin_amdgcn_sched_group_barrier(0x008, 1, 0); __builtin_amdgcn_sched_group_barrier(0x002, 7, 0); } } \
            if (pend) { _Pragma("unroll") for (int db = 0; db < 4; ++db) _Pragma("unroll") for (int e = 0; e < 16; ++e) o[db][e] *= fp; pend = false; } \
            ATT_DMA_K(kw); ATT_DMA_V(vw); \
            if (i_ + 2 < 127) ATT_ADV_K(); \
            if (i_ + 1 < 127) ATT_ADV_V(); \
            kr = (kr == 2 * KB) ? 0 : kr + KB; kw = (kw == 2 * KB) ? 0 : kw + KB; \
            vr = (vr == 2 * VB) ? 0 : vr + VB; vw = (vw == 2 * VB) ? 0 : vw + VB; \
            asm volatile("s_waitcnt vmcnt(4) lgkmcnt(0)\n\ts_barrier" ::: "memory"); } while (0)
            ATT1_ITER(pfB, pf, 0, false);
            for (int i2 = 1; i2 < 127; i2 += 2) {
                ATT1_ITER(pf, pfB, i2, true);
                ATT1_ITER(pfB, pf, i2 + 1, true);
            }
            ATT1_ITER(pf, pfB, 127, true);
#undef ATT1_ITER
#pragma unroll
            for (int q = 0; q < 4; ++q) pf[q] = pfB[q];
        } else {
        for (int i = 0; i < 128; ++i) {
            att_qk<MODE>(S0, S1, lds + kr, ka, qf);
            const float rm = att_rowmax(S0, S1);
            if (i == 0) mhat = rm;
            else if (__any(rm - mhat > THR)) { const float dl = fmaxf(rm - mhat, 0.f), f = __builtin_amdgcn_exp2f(-dl); lrun *= f; mhat += dl; fpend = f; havepend = true; }
            if (i > 0) att_pv(o, vring + vr, va, pf);
            att_exp(S0, S1, mhat, lrun, pf);
            ATT_RESC_O();
            ATT_DMA_K(kw); ATT_DMA_V(vw);
            if (i + 2 < 127) ATT_ADV_K();
            if (i + 1 < 127) ATT_ADV_V();
            kr = (kr == 2 * KB) ? 0 : kr + KB; kw = (kw == 2 * KB) ? 0 : kw + KB;
            vr = (vr == 2 * VB) ? 0 : vr + VB; vw = (vw == 2 * VB) ? 0 : vw + VB;
            asm volatile("s_waitcnt vmcnt(5) lgkmcnt(0)\n\ts_barrier" ::: "memory");
        }
        }
        att_pv(o, vring + vr, va, pf);
        asm volatile("s_waitcnt vmcnt(0) lgkmcnt(0)\n\ts_barrier" ::: "memory");
#undef ATT_DMA_K
#undef ATT_DMA_V
#undef ATT_ADV_K
#undef ATT_ADV_V
#undef ATT_RESC_O
        lrun = xor32_add(lrun);
        const float inv = 1.0f / lrun;
        bf16* orow = CAT + qrow * DM + h * 128;
        if (MODE == 0) {
#pragma unroll
            for (int db = 0; db < 4; ++db)
#pragma unroll
                for (int g4 = 0; g4 < 4; ++g4) {
                    const u32x2 w = {pk2(o[db][4 * g4] * inv, o[db][4 * g4 + 1] * inv), pk2(o[db][4 * g4 + 2] * inv, o[db][4 * g4 + 3] * inv)};
                    *(u32x2*)(orow + 32 * db + 8 * g4 + 4 * hh) = w;
                }
        } else {
            LAS float* ex = (LAS float*)lds + wq * 4096 + lane;
            if (map == 1) {
                const float f = lam * inv;
#pragma unroll
                for (int db = 0; db < 4; ++db)
#pragma unroll
                    for (int i = 0; i < 16; ++i) ex[(db * 16 + i) * 64] = o[db][i] * f;
            }
            __syncthreads();
            if (map == 0) {
                float ss = 0.f;
#pragma unroll
                for (int db = 0; db < 4; ++db)
#pragma unroll
                    for (int i = 0; i < 16; ++i) { const float v = o[db][i] * inv - ex[(db * 16 + i) * 64]; o[db][i] = v; ss += v * v; }
                ss = xor32_add(ss);
                const float rstd = rsqrtf(ss * (1.f / 128.f) + EPS);
#pragma unroll
                for (int db = 0; db < 4; ++db)
#pragma unroll
                    for (int g4 = 0; g4 < 4; ++g4) {
                        const u32x2 w = {pk2(o[db][4 * g4] * rstd, o[db][4 * g4 + 1] * rstd), pk2(o[db][4 * g4 + 2] * rstd, o[db][4 * g4 + 3] * rstd)};
                        *(u32x2*)(orow + 32 * db + 8 * g4 + 4 * hh) = w;
                    }
            }
            __syncthreads();
        }
    }
}

constexpr size_t WS_CTL = 5 * MiB, CTL_BYTES = 16384;
#define XB_TMO      128
#define XB_XCNT(j)  (256  + 64 * (j))
#define XB_XSUB(j)  (1280 + 64 * (j))
#define XB_XGEN(j)  (2304 + 64 * (j))
#define XB_TOP      3328
#define XB_TOPGEN   3392
#define XCD_BAR_WORDS 3456
#define XB_SPIN_CAP (1u << 18)

__device__ __forceinline__ unsigned xb_ld(unsigned* p)              { return __hip_atomic_load(p, __ATOMIC_RELAXED, __HIP_MEMORY_SCOPE_AGENT); }
__device__ __forceinline__ unsigned xb_add(unsigned* p, unsigned v) { return __hip_atomic_fetch_add(p, v, __ATOMIC_RELAXED, __HIP_MEMORY_SCOPE_AGENT); }
__device__ __forceinline__ unsigned xb_xcc_id() { return (unsigned)__builtin_amdgcn_s_getreg((3 << 11) | 20) & 0xFu; }
#define XB_SPIN(cond, bar) do { unsigned _sp = 0; while (cond) { __builtin_amdgcn_s_sleep(1); \
    if ((++_sp & 255u) == 0u) { if (xb_ld(&(bar)[XB_TMO])) break; if (_sp > XB_SPIN_CAP) { atomicAdd(&(bar)[XB_TMO], 1u); break; } } } } while (0)

struct XcdBarrier {
    unsigned* bar; unsigned x;
    volatile LAS unsigned* st;
};

__device__ __forceinline__ XcdBarrier xcd_barrier_post(unsigned* bar, volatile LAS unsigned* st) {
    XcdBarrier b; b.bar = bar; b.x = xb_xcc_id(); b.st = st;
    if (threadIdx.x == 0) (void)xb_add(&bar[XB_XCNT(b.x)], 1u);
    return b;
}
__device__ __forceinline__ void xcd_barrier_complete(unsigned* bar, unsigned x, unsigned& nloc, unsigned& nx) {
    const unsigned G = gridDim.x * gridDim.y * gridDim.z;
    unsigned sum, cnt, mine, sp = 0u;
    for (;;) {
        sum = 0u; cnt = 0u; mine = 0u;
#pragma unroll
        for (unsigned j = 0; j < 16; ++j) { const unsigned c = xb_ld(&bar[XB_XCNT(j)]); sum += c; cnt += (c > 0u) ? 1u : 0u; mine = (j == x) ? c : mine; }
        if (sum == G) break;
        __builtin_amdgcn_s_sleep(1);
        if ((++sp & 255u) == 0u) { if (xb_ld(&bar[XB_TMO])) break; if (sp > XB_SPIN_CAP) { atomicAdd(&bar[XB_TMO], 1u); break; } }
    }
    nloc = mine > 0u ? mine : 1u; nx = cnt > 0u ? cnt : 1u;
}

__device__ __forceinline__ void xcd_barrier(const XcdBarrier& b) {
    asm volatile("s_waitcnt vmcnt(0)" ::: "memory");
    __syncthreads();
    if (threadIdx.x == 0) {
        unsigned* bar = b.bar;
        __builtin_amdgcn_s_waitcnt(0);
        unsigned nloc = b.st[0], nx = b.st[1];
        if (nloc == 0u) { xcd_barrier_complete(bar, b.x, nloc, nx); b.st[0] = nloc; b.st[1] = nx; }
        const unsigned old = xb_add(&bar[XB_XSUB(b.x)], 1u);
        const unsigned gen = old / nloc;
        if (old + 1u == (gen + 1u) * nloc) {
            __builtin_amdgcn_fence(__ATOMIC_RELEASE, "agent");
            asm volatile("s_waitcnt vmcnt(0)" ::: "memory");
            const unsigned og = xb_add(&bar[XB_TOP], 1u);
            const unsigned tg = og / nx;
            if (og + 1u == (tg + 1u) * nx) xb_add(&bar[XB_TOPGEN], 1u);
            else XB_SPIN(xb_ld(&bar[XB_TOPGEN]) == tg, bar);
            __builtin_amdgcn_fence(__ATOMIC_ACQUIRE, "agent");
            xb_add(&bar[XB_XGEN(b.x)], 1u);
            asm volatile("s_waitcnt vmcnt(0)" ::: "memory");
        } else {
            XB_SPIN(xb_ld(&bar[XB_XGEN(b.x)]) == gen, bar);
            __builtin_amdgcn_fence(__ATOMIC_ACQUIRE, "agent");
            asm volatile("s_waitcnt vmcnt(0)" ::: "memory");
        }
    }
    __syncthreads();
}

#ifndef MK_SINGLE
#define MK_SINGLE 1
#endif
constexpr int NPHASES = 47;
constexpr int LDS_BYTES = 147456;
struct Args { const float* in[34]; float* out; unsigned char* ws; double inv_m[32]; double inv_d[8]; int lo, hi; };

__global__ void __launch_bounds__(512, 2) mk_fwd(Args args) {
    extern __shared__ __attribute__((aligned(16))) unsigned char lds_raw[];
    LAS unsigned char* lds = (LAS unsigned char*)lds_raw;
    cg::grid_group grid = cg::this_grid();
    volatile LAS unsigned* xst = (volatile LAS unsigned*)(lds + 147456 - 64);
    if (threadIdx.x < 2) xst[threadIdx.x] = 0u;
    __syncthreads();
    if (args.hi - args.lo > 1) (void)xcd_barrier_post((unsigned*)(args.ws + WS_CTL), xst);
    const int lo = args.lo, hi = args.hi;
    int ph = 0;
#define PH_BEGIN if (ph >= lo && ph < hi) { \
    int tid_ = threadIdx.x; asm volatile("" : "+v"(tid_)); int zz_ = 0; asm volatile("" : "+s"(zz_)); \
    const int tid = tid_, lane = tid & 63, wave = __builtin_amdgcn_readfirstlane(tid >> 6); \
    const int G = gridDim.x, bx = blockIdx.x + zz_; \
    const int vcu = (G % 8 == 0) ? (bx % 8) * (G / 8) + bx / 8 : bx; \
    const int gw = bx * 8 + wave, NGW = G * 8; \
    unsigned char* ws = args.ws + zz_; \
    float* cosm = (float*)(ws + WS_COSM); float* sinm = (float*)(ws + WS_SINM); float* cosd = (float*)(ws + WS_COSD); float* sind = (float*)(ws + WS_SIND); \
    float2* s5A = (float2*)(ws + WS_S5A); float2* s5A64 = (float2*)(ws + WS_S5A64); bf16* s5BB = (bf16*)(ws + WS_S5BB); bf16* s5CT = (bf16*)(ws + WS_S5CT); \
    float* lamtab = (float*)(ws + WS_LAM); \
    bf16* Wb = (bf16*)(ws + WS_W); \
    bf16* XN = (bf16*)(ws + WS_XN); bf16* CAT = XN; \
    unsigned char* R1 = ws + WS_R1; \
    bf16* Hb = (bf16*)(R1 + R_H); \
    float* ZA = (float*)(R1 + R_ZA); float* Ub = (float*)(R1 + R_U); \
    bf16* Qb = (bf16*)(R1 + R_Q); bf16* KNb = (bf16*)(R1 + R_KN); bf16* VTb = (bf16*)(R1 + R_VT); \
    bf16* ZQN = (bf16*)(R1 + R_ZQN); bf16* ZKVN = (bf16*)(R1 + R_ZKVN); bf16* KPE = (bf16*)(R1 + R_KPE); bf16* YGb = (bf16*)(R1 + R_YGB); \
    float2* SLOC = (float2*)(R1 + R_SLOC); float2* CARRY = (float2*)(R1 + R_CARRY); \
    bf16* QD = (bf16*)(R1 + R_QD); bf16* KD = (bf16*)(R1 + R_KD); bf16* VTD = (bf16*)(R1 + R_VTD); \
    float* X = args.out + zz_; \
    const int j = (layer_ >> 1) + zz_; (void)j; \
    bf16* wl = Wb + (size_t)(layer_ + zz_) * W_FFN_L; bf16* we = Wb + W_EVEN0 + (size_t)j * W_EVEN_L; bf16* wo = Wb + W_ODD0 + (size_t)j * W_ODD_L; const int tb = j * 64; \
    (void)tid; (void)lane; (void)wave; (void)vcu; (void)gw; (void)NGW; (void)cosm; (void)sinm; (void)cosd; (void)sind; (void)s5A; (void)s5A64; (void)s5BB; (void)s5CT; (void)lamtab; (void)Wb; (void)XN; (void)CAT; \
    (void)Hb; (void)ZA; (void)Ub; (void)Qb; (void)KNb; (void)VTb; (void)ZQN; (void)ZKVN; (void)KPE; (void)YGb; (void)SLOC; (void)CARRY; (void)QD; (void)KD; (void)VTD; (void)X; (void)wl; (void)we; (void)wo; (void)tb;
#define PH_END   if (ph + 1 < hi) { if (hi < 0) grid.sync();   else { XcdBarrier xb_; xb_.bar = (unsigned*)ws + WS_CTL / 4; xb_.x = xb_xcc_id(); xb_.st = (volatile LAS unsigned*)(lds + 147456 - 64); xcd_barrier(xb_); } } } ++ph;
    int layer_ = 0;

    PH_BEGIN
#pragma unroll 1
        for (int i = 0; i < 4; ++i) {
            bf16* wlp = Wb + (size_t)i * W_FFN_L;
            const size_t o1 = (size_t)i * DM * FF;
            prep_w(args.in[2] + o1, DM, FF, wlp + W_GU1, 4, 1, 0, args.in[1] + i * DM, 0x7fffffff, 1.f, gw, NGW, lane, (LAS float*)(lds + wave * 8704));
            prep_w(args.in[3] + o1, DM, FF, wlp + W_GU1, 4, 1, 128, args.in[1] + i * DM, 0x7fffffff, 1.f, gw, NGW, lane, (LAS float*)(lds + wave * 8704));
            prep_w(args.in[4] + o1, FF, DM, wlp + W_D1, 0, 1, 0, nullptr, 0, 0.5f, gw, NGW, lane, (LAS float*)(lds + wave * 8704));
            prep_w(args.in[7] + o1, DM, FF, wlp + W_GU2, 4, 1, 0, args.in[6] + i * DM, 0x7fffffff, 1.f, gw, NGW, lane, (LAS float*)(lds + wave * 8704));
            prep_w(args.in[8] + o1, DM, FF, wlp + W_GU2, 4, 1, 128, args.in[6] + i * DM, 0x7fffffff, 1.f, gw, NGW, lane, (LAS float*)(lds + wave * 8704));
            prep_w(args.in[9] + o1, FF, DM, wlp + W_D2, 0, 1, 0, nullptr, 0, 0.5f, gw, NGW, lane, (LAS float*)(lds + wave * 8704));
        }
#pragma unroll 1
        for (int jj = 0; jj < 2; ++jj) { const int j = jj;
            bf16* we = Wb + W_EVEN0 + (size_t)j * W_EVEN_L;
            prep_w(args.in[10] + (size_t)j * DM * 1344, DM, 1344, we + W_WIN, 0, 1, 0, args.in[5] + (2 * j) * DM, 0x7fffffff, 1.f, gw, NGW, lane, (LAS float*)(lds + wave * 8704));
            for (int idx = gw * 64 + lane; idx < 192 * DM / 8; idx += NGW * 64) ((u32x4*)(we + W_WIN + (size_t)1344 * DM))[idx] = (u32x4){0u, 0u, 0u, 0u};
            prep_w(args.in[12] + (size_t)j * 512 * 768, 512, 768, we + W_QUP, 2, 1, 0, args.in[11] + j * 512, 0x7fffffff, 1.f, gw, NGW, lane, (LAS float*)(lds + wave * 8704));
            prep_w(args.in[14] + (size_t)j * 256 * 1024, 256, 1024, we + W_KVUP, 0, 1, 0, args.in[13] + j * 256, 0x7fffffff, 1.f, gw, NGW, lane, (LAS float*)(lds + wave * 8704));
            prep_w(args.in[23] + (size_t)j * 512 * 512, 512, 512, we + W_GLU, 0, 1, 0, nullptr, 0, 1.f, gw, NGW, lane, (LAS float*)(lds + wave * 8704));
            prep_w(args.in[25] + (size_t)j * DM * DM, DM, DM, we + W_WOUT, 0, 1, 0, nullptr, 0, 1.f, gw, NGW, lane, (LAS float*)(lds + wave * 8704));
            bf16* wo = Wb + W_ODD0 + (size_t)j * W_ODD_L;
            const float lam_init = 0.8f - 0.6f * expf(-0.3f * (float)(2 * j + 1));
            prep_w(args.in[26] + (size_t)j * DM * 3072, DM, 3072, wo + W_DIN, 3, 1, 0, args.in[5] + (2 * j + 1) * DM, 0x7fffffff, 1.f, gw, NGW, lane, (LAS float*)(lds + wave * 8704));
            prep_w(args.in[32] + (size_t)j * DM * DM, DM, DM, wo + W_DOUT, 0, 1, 0, args.in[31] + j * 128, 127, 1.f - lam_init, gw, NGW, lane, (LAS float*)(lds + wave * 8704));
        }
        for (int idx = bx * 512 + tid; idx < SEQ * 32; idx += G * 512) {
            const int pos = idx >> 5, t = idx & 31;
            const double rev = (double)pos * args.inv_m[t] * 0.15915494309189535; const float fr = (float)(rev - rint(rev));
            cosm[idx] = __builtin_amdgcn_cosf(fr); sinm[idx] = __builtin_amdgcn_sinf(fr);
        }
        for (int idx = bx * 512 + tid; idx < SEQ * 8; idx += G * 512) {
            const int pos = idx >> 3, t = idx & 7;
            const double rev = (double)pos * args.inv_d[t] * 0.15915494309189535; const float fr = (float)(rev - rint(rev));
            cosd[idx] = __builtin_amdgcn_cosf(fr); sind[idx] = __builtin_amdgcn_sinf(fr);
        }
        for (int idx = bx * 512 + tid; idx < 8192; idx += G * 512) {
            const int p = idx & 63, g = (idx >> 6) & 31, jd = idx >> 11;
            const float lr = args.in[15][idx], li = args.in[16][idx];
            const float dt = __expf(args.in[17][jd * 32 + g]);
            const float mag = __expf(lr * dt);
            const double rev = (double)(li * dt) * 0.15915494309189535; const float fr = (float)(rev - rint(rev));
            const float ar = mag * __builtin_amdgcn_cosf(fr), ai = mag * __builtin_amdgcn_sinf(fr);
            const float den = lr * lr + li * li, nr = ar - 1.0f;
            const float cre = (nr * lr + ai * li) / den, cim = (ai * lr - nr * li) / den;
            s5A[idx] = make_float2(ar, ai);
            float pr = ar, pi = ai;
#pragma unroll
            for (int q = 0; q < 6; ++q) { const float tr = pr * pr - pi * pi, ti = 2.f * pr * pi; pr = tr; pi = ti; }
            s5A64[idx] = make_float2(pr, pi);
            const float* br = args.in[18] + (size_t)idx * 16; const float* bi = args.in[19] + (size_t)idx * 16;
            const int colp = p & 31, half = p >> 5;
            bf16* bre = s5BB + ((size_t)(jd * 32 + g) * 128 + (2 * half) * 32 + colp) * 16;
            bf16* bim = s5BB + ((size_t)(jd * 32 + g) * 128 + (2 * half + 1) * 32 + colp) * 16;
#pragma unroll
            for (int c = 0; c < 16; c += 2) {
                const float r0 = cre * br[c] - cim * bi[c], r1 = cre * br[c + 1] - cim * bi[c + 1];
                const float i0 = cre * bi[c] + cim * br[c], i1 = cre * bi[c + 1] + cim * br[c + 1];
                *(unsigned*)(bre + c) = pk2(r0, r1); *(unsigned*)(bim + c) = pk2(i0, i1);
            }
            const float* cr = args.in[20] + (size_t)(jd * 32 + g) * 1024; const float* ci = args.in[21] + (size_t)(jd * 32 + g) * 1024;
            bf16* ct = s5CT + (size_t)(jd * 32 + g) * 2048;
#pragma unroll 4
            for (int c = 0; c < 16; ++c) *(unsigned*)(ct + c * 128 + 4 * colp + 2 * half) = pk2(cr[c * 64 + p], -ci[c * 64 + p]);
        }
        if (bx == 0 && tid < 2) {
            const int j = tid; float d1 = 0.f, d2 = 0.f;
            for (int e = 0; e < 64; ++e) { d1 += args.in[27][j * 64 + e] * args.in[28][j * 64 + e]; d2 += args.in[29][j * 64 + e] * args.in[30][j * 64 + e]; }
            lamtab[j] = expf(d1) - expf(d2) + (0.8f - 0.6f * expf(-0.3f * (float)(2 * j + 1)));
        }
        norm_rows(args.in[0], XN, gw, NGW, lane);
    PH_END

#pragma unroll 1
    for (int layer = 0; layer < 4; ++layer) {
        layer_ = layer;
#pragma unroll 1
        for (int half = 0; half < 2; ++half) {
            if (half == 1) {
                PH_BEGIN norm_rows(X, XN, gw, NGW, lane); PH_END
                if ((layer & 1) == 0) {
                    PH_BEGIN {
                        pg8::Gemm g{XN, we + W_WIN, M, ZN, DM}; pg8::StaticOrder S; S.init(M, ZN, G, bx);
                        EpiZ E{ZA, Ub};
                        pg8::gemm_phase<EpiZ, pg8::StaticOrder, true, true>(lds, g, S, E);
                    } PH_END
                    PH_BEGIN
                        post_rows(ZA, ZQN, ZKVN, KPE, cosm, sinm, gw, NGW, lane);
                        s5_pass<false>(lds + wave * 8704, Ub, s5A + (size_t)tb * 64, s5BB + (size_t)tb * 2048, s5CT + (size_t)tb * 2048, SLOC, CARRY, nullptr, nullptr, gw, NGW, lane);
                    PH_END
                    PH_BEGIN
                        s5_passB(s5A64 + (size_t)tb * 64, SLOC, CARRY);
                        {
                            pg8::Gemm g{ZQN, we + W_QUP, M, 768, 512}; pg8::StaticOrder S; S.init(M, 768, G, bx);
                            EpiQ E{Qb, cosm, sinm, 0.07216878364870322f * LOG2E};
                            pg8::gemm_phase<EpiQ, pg8::StaticOrder, true, true>(lds, g, S, E);
                        }
                        {
                            pg8::Gemm g{ZKVN, we + W_KVUP, M, 1024, 256}; pg8::StaticOrder S; S.init(M, 1024, G, bx);
                            EpiKV E{KNb, VTb};
                            pg8::gemm_phase<EpiKV, pg8::StaticOrder, true, true>(lds, g, S, E);
                        }
                    PH_END
                    PH_BEGIN
                        attn_phase<0>(lds, Qb, KNb, KPE, VTb, CAT, 0.f, vcu, G);
                        s5_pass<true>(lds + wave * 8704, Ub, s5A + (size_t)tb * 64, s5BB + (size_t)tb * 2048, s5CT + (size_t)tb * 2048, SLOC, CARRY, args.in[22] + j * 512, YGb, gw, NGW, lane);
                    PH_END
                    PH_BEGIN {
                        pg8::Gemm g{YGb, we + W_GLU, M, 512, 512}; pg8::StaticOrder S; S.init(M, 512, G, bx);
                        EpiGlu E{YGb, args.in[24] + j * 512, CAT};
                        pg8::gemm_phase<EpiGlu, pg8::StaticOrder, true, true>(lds, g, S, E);
                    } PH_END
                    PH_BEGIN {
                        pg8::Gemm g{CAT, we + W_WOUT, M, DM, DM}; pg8::StaticOrder S; S.init(M, DM, G, bx);
                        EpiResid E{X, X};
                        pg8::gemm_phase<EpiResid, pg8::StaticOrder, true, true>(lds, g, S, E);
                    } PH_END
                } else {
                    PH_BEGIN {
                        pg8::Gemm g{XN, wo + W_DIN, M, 3072, DM}; pg8::StaticOrder S; S.init(M, 3072, G, bx);
                        EpiDiffIn E{QD, KD, VTD, cosd, sind, 0.125f * LOG2E};
                        pg8::gemm_phase<EpiDiffIn, pg8::StaticOrder, true, true>(lds, g, S, E);
                    } PH_END
                    PH_BEGIN
                        attn_phase<1>(lds, QD, KD, nullptr, VTD, CAT, lamtab[j], vcu, G);
                    PH_END
                    PH_BEGIN {
                        pg8::Gemm g{CAT, wo + W_DOUT, M, DM, DM}; pg8::StaticOrder S; S.init(M, DM, G, bx);
                        EpiResid E{X, X};
                        pg8::gemm_phase<EpiResid, pg8::StaticOrder, true, true>(lds, g, S, E);
                    } PH_END
                }
                PH_BEGIN norm_rows(X, XN, gw, NGW, lane); PH_END
            }
            PH_BEGIN {
                pg8::Gemm g{XN, wl + (half ? W_GU2 : W_GU1), M, NGU, DM}; pg8::StaticOrder S; S.init(M, NGU, G, bx);
                EpiSwiglu E{Hb};
                pg8::gemm_phase<EpiSwiglu, pg8::StaticOrder, true, true>(lds, g, S, E);
            } PH_END
            PH_BEGIN {
                pg8::Gemm g{Hb, wl + (half ? W_D2 : W_D1), M, DM, FF}; pg8::StaticOrder S; S.init(M, DM, G, bx);
                EpiResid E{(layer == 0 && half == 0) ? args.in[0] : (const float*)X, X};
                pg8::gemm_phase<EpiResid, pg8::StaticOrder, true, true>(lds, g, S, E);
            } PH_END
        }
        if (layer < 3) { PH_BEGIN norm_rows(X, XN, gw, NGW, lane); PH_END }
    }
    PH_BEGIN final_norm_rows(X, args.in[33], gw, NGW, lane); PH_END
#undef PH_BEGIN
#undef PH_END
}

extern "C" void kernel_launch(void* const* d_in, const int* in_sizes, int n_in, void* d_out, int out_size, void* d_ws, size_t ws_size, hipStream_t stream) {
    static int grid = 0;
    if (grid == 0) {
        if (n_in != 34 || out_size != M * DM || ws_size < WS_NEED) { fprintf(stderr, "kernel_launch: unexpected shapes (n_in %d out %d ws %zu)\n", n_in, out_size, ws_size); grid = -1; return; }
        int dev = 0, cus = 0, per_cu = 0;
        (void)hipGetDevice(&dev); (void)hipDeviceGetAttribute(&cus, hipDeviceAttributeMultiprocessorCount, dev);
        if (hipFuncSetAttribute((const void*)mk_fwd, hipFuncAttributeMaxDynamicSharedMemorySize, LDS_BYTES) != hipSuccess) { fprintf(stderr, "kernel_launch: hipFuncSetAttribute failed\n"); grid = -1; return; }
        if (hipOccupancyMaxActiveBlocksPerMultiprocessor(&per_cu, (const void*)mk_fwd, 512, LDS_BYTES) != hipSuccess || per_cu < 1) { fprintf(stderr, "kernel_launch: occupancy query says %d\n", per_cu); per_cu = 1; }
        (void)hipGetLastError();
        grid = cus * 1;
        if (grid <= 0) grid = 256;
    }
    if (grid < 0) return;
    (void)hipMemsetAsync((unsigned char*)d_ws + WS_CTL, 0, CTL_BYTES, stream);
    Args a; memset(&a, 0, sizeof(a));
    for (int i = 0; i < 34; ++i) a.in[i] = (const float*)d_in[i];
    a.out = (float*)d_out; a.ws = (unsigned char*)d_ws;
    for (int t = 0; t < 32; ++t) a.inv_m[t] = pow(500000.0, -(double)(2 * t) / 64.0);
    for (int t = 0; t < 8; ++t) a.inv_d[t] = pow(500000.0, -(double)(2 * t) / 16.0);
#if MK_SINGLE
    a.lo = 0; a.hi = NPHASES;
    void* kargs[] = {&a};
    hipError_t e = hipLaunchCooperativeKernel((const void*)mk_fwd, dim3(grid), dim3(512), kargs, LDS_BYTES, stream);
    if (e != hipSuccess) fprintf(stderr, "kernel_launch: cooperative launch failed: %s (grid %d)\n", hipGetErrorString(e), grid);
#else
    for (int p = 0; p < NPHASES; ++p) {
        a.lo = p; a.hi = p + 1;
        hipLaunchKernelGGL(mk_fwd, dim3(grid), dim3(512), LDS_BYTES, stream, a);
    }
#endif
}
```

```cpp
#include <hip/hip_runtime.h>
#include <hip/hip_cooperative_groups.h>
#include <cstdio>
#include <cstdint>
#include <cstring>
#include <cmath>
namespace cg = cooperative_groups;
namespace pg8 {
#define PG8_LAS __attribute__((address_space(3)))
typedef unsigned short bf16_t;
typedef short bf16x8 __attribute__((ext_vector_type(8)));
typedef float f32x4 __attribute__((ext_vector_type(4)));
typedef unsigned u32x4 __attribute__((ext_vector_type(4)));
constexpr int BM = 256, BK = 64, HALF = 128, HTB = HALF * BK * 2  , STAGE_BYTES = 8 * HTB, NXCD = 8, WGM = 8;

__host__ __device__ __forceinline__ int lds_byte(int r, int c) { const int st = (r >> 4) * 2 + (c >> 5), rr = r & 15, cc = c & 31, ob = rr * 64 + cc * 2; return st * 1024 + (ob ^ (((ob >> 9) & 1) << 5)); }
__host__ __device__ __forceinline__ void stage_rc(int b, int& R, int& C) { const int st = b / 1024, sb = b % 1024, swz = sb ^ (((sb >> 9) & 1) << 5); R = (st >> 1) * 16 + swz / 64; C = (st & 1) * 32 + (swz % 64) / 2; }
__host__ __device__ __forceinline__ int perm32(int rho) { const int n = rho >> 4, i = rho & 15; return 8 * (i >> 2) + 4 * n + (i & 3); }

struct Unit { int pm, pn; };
struct Gemm { const bf16_t* A; const bf16_t* Bt; int M, N, K; };

struct StaticOrder {
    int nM, nN, nwg, G, c;
    __host__ __device__ void init(int M, int N, int G_, int c_) { nM = M / BM; nN = N / BM; nwg = nM * nN; G = G_; c = c_; }
    __host__ __device__ bool next(int i, Unit& u) const {
        const long L = (long)i * G + c; if (L >= nwg) return false;
        int wgid = (int)L; { const int q = nwg / NXCD, r = nwg % NXCD, xcd = wgid % NXCD, off = wgid / NXCD; wgid = (xcd < r ? xcd * (q + 1) : r * (q + 1) + (xcd - r) * q) + off; }
        const int nig = WGM * nN, gid = wgid / nig, fm = gid * WGM, gsz = (nM - fm) < WGM ? (nM - fm) : WGM;
        u.pm = fm + ((wgid % nig) % gsz); u.pn = (wgid % nig) / gsz; return true;
    }
    __device__ __forceinline__ void a_ready(const Unit&) const {}
    __device__ __forceinline__ void done(const Unit&) const {}
};

__device__ __forceinline__ unsigned cvt_pk_bf16(float lo, float hi) { unsigned r; asm volatile("v_cvt_pk_bf16_f32 %0, %1, %2" : "=v"(r) : "v"(lo), "v"(hi)); return r; }
typedef float f32x2 __attribute__((ext_vector_type(2)));
template <class Epi, class Sched, bool ALIGN_EPI = false, bool SP2 = false>
__device__ __forceinline__ void gemm_phase(PG8_LAS unsigned char* lds, const Gemm g, const Sched& S, const Epi& E) {
    int tid_ = threadIdx.x; asm volatile("" : "+v"(tid_)); const int tid = tid_, wid = __builtin_amdgcn_readfirstlane(tid >> 6), lane = tid & 63, wr = wid >> 2, wc = wid & 3, fr = lane & 15, fq = lane >> 4;
    const int K = g.K, nt = K / BK;
    unsigned voffA[2], voffB[2];
#pragma unroll
    for (int i = 0; i < 2; ++i) { int R, C; stage_rc(tid * 16 + i * 8192, R, C); const int Rb = Epi::PERM ? ((R & ~31) + perm32(R & 31)) : R;
        voffA[i] = (unsigned)(R * K + C) * 2u; voffB[i] = (unsigned)(Rb * K + C) * 2u; }
    const size_t kstep = (size_t)(BK * 2);
    const size_t hstep = (size_t)HALF * K * 2;
    const size_t tstep = 2 * hstep;
    const unsigned ldsw = (unsigned)wid * 1024u;
    const int aoff = lds_byte(wr * 64 + fr, fq * 8), boff = lds_byte(wc * 32 + fr, fq * 8);
#define PG8_SA(b, h) (((b) * 2 + (h)) * HTB)
#define PG8_SB(b, h) ((4 + (b) * 2 + (h)) * HTB)
#define PG8_STAGE(bufoff, gbase, voff) do { _Pragma("unroll") for (int _i = 0; _i < 2; ++_i) \
        __builtin_amdgcn_global_load_lds((const unsigned*)((const char*)(gbase) + (voff)[_i]), (PG8_LAS unsigned*)(lds + (bufoff) + ldsw + _i * 8192), 16, 0, 0); } while (0)
#define PG8_LDA(dst, b, h) do { _Pragma("unroll") for (int m = 0; m < 4; ++m) _Pragma("unroll") for (int k = 0; k < 2; ++k) dst[m][k] = *(const PG8_LAS bf16x8*)(lds + PG8_SA(b, h) + aoff + m * 2048 + k * 1024); } while (0)
#define PG8_LDB(dst, b, h) do { _Pragma("unroll") for (int n = 0; n < 2; ++n) _Pragma("unroll") for (int k = 0; k < 2; ++k) dst[n][k] = *(const PG8_LAS bf16x8*)(lds + PG8_SB(b, h) + boff + n * 2048 + k * 1024); } while (0)
#define PG8_MMA(ai, bj, At, Bt) do { __builtin_amdgcn_s_setprio(1); _Pragma("unroll") for (int m = 0; m < 4; ++m) _Pragma("unroll") for (int n = 0; n < 2; ++n) _Pragma("unroll") for (int k = 0; k < 2; ++k) \
        acc[ai][bj][m][n] = __builtin_amdgcn_mfma_f32_16x16x32_bf16(Bt[n][k], At[m][k], acc[ai][bj][m][n], 0, 0, 0); __builtin_amdgcn_s_setprio(0); } while (0)
#define PG8_WAIT_V(n) asm volatile("s_waitcnt vmcnt(" #n ")" ::: "memory")
#define PG8_WAIT_L(n) asm volatile("s_waitcnt lgkmcnt(" #n ")" ::: "memory")
#define PG8_BAR __builtin_amdgcn_s_barrier()
#define PG8_SCHED __builtin_amdgcn_sched_barrier(0)
    Unit cur, nxt; int ui = 0;
    if (!S.next(0, cur)) return;
    f32x4 acc[2][2][4][2];
#pragma unroll
    for (int a = 0; a < 2; ++a)
#pragma unroll
        for (int b = 0; b < 2; ++b)
#pragma unroll
            for (int m = 0; m < 4; ++m)
#pragma unroll
                for (int n = 0; n < 2; ++n) acc[a][b][m][n] = (f32x4){0.f, 0.f, 0.f, 0.f};
    bf16x8 At[4][2], B0[2][2], B1[2][2];
    const char* cA = (const char*)g.A + (size_t)cur.pm * tstep; const char* cB = (const char*)g.Bt + (size_t)cur.pn * tstep;
    S.a_ready(cur);
    if constexpr (SP2) {
        PG8_STAGE(PG8_SB(0, 0), cB, voffB); PG8_STAGE(PG8_SB(0, 1), cB + hstep, voffB); PG8_STAGE(PG8_SA(0, 0), cA, voffA); PG8_STAGE(PG8_SA(0, 1), cA + hstep, voffA);
        if (wr == 1) PG8_BAR;
        PG8_WAIT_V(2); PG8_BAR;
        PG8_STAGE(PG8_SB(1, 0), cB + kstep, voffB); PG8_STAGE(PG8_SA(1, 0), cA + kstep, voffA); PG8_STAGE(PG8_SB(1, 1), cB + hstep + kstep, voffB);
        PG8_WAIT_V(6); PG8_BAR;
    } else {
        PG8_STAGE(PG8_SB(0, 0), cB, voffB); PG8_STAGE(PG8_SA(0, 0), cA, voffA); PG8_STAGE(PG8_SB(0, 1), cB + hstep, voffB); PG8_STAGE(PG8_SA(0, 1), cA + hstep, voffA);
        if (wr == 1) PG8_BAR;
        PG8_WAIT_V(4); PG8_BAR;
        PG8_STAGE(PG8_SB(1, 0), cB + kstep, voffB); PG8_STAGE(PG8_SA(1, 0), cA + kstep, voffA); PG8_STAGE(PG8_SB(1, 1), cB + hstep + kstep, voffB);
        PG8_WAIT_V(6); PG8_BAR;
    }
    for (;;) {
        const bool has_next = S.next(ui + 1, nxt);
        const char* nA = has_next ? (const char*)g.A + (size_t)nxt.pm * tstep : cA; const char* nB = has_next ? (const char*)g.Bt + (size_t)nxt.pn * tstep : cB;
        for (int t = 0; t < nt; t += 2) {
            const bool last = (t == nt - 2);
            const char* a1 = cA + (size_t)(t + 1) * kstep;
            const char* a2 = last ? nA : cA + (size_t)(t + 2) * kstep; const char* b2 = last ? nB : cB + (size_t)(t + 2) * kstep;
            const char* a3 = a2 + kstep; const char* b3 = b2 + kstep;
            if (last && has_next) S.a_ready(nxt);
            if constexpr (SP2) {
            PG8_LDB(B0, 0, 0); PG8_LDB(B1, 0, 1); PG8_SCHED; PG8_LDA(At, 0, 0); PG8_STAGE(PG8_SA(1, 1), a1 + hstep, voffA);
            PG8_WAIT_V(8); PG8_WAIT_L(0); PG8_BAR; PG8_MMA(0, 0, At, B0); PG8_MMA(0, 1, At, B1); PG8_BAR; PG8_SCHED;
            PG8_LDA(At, 0, 1); PG8_STAGE(PG8_SB(0, 0), b2, voffB); PG8_STAGE(PG8_SB(0, 1), b2 + hstep, voffB); PG8_STAGE(PG8_SA(0, 0), a2, voffA);
            PG8_WAIT_V(8); PG8_WAIT_L(0); PG8_BAR; PG8_MMA(1, 0, At, B0); PG8_MMA(1, 1, At, B1); PG8_BAR; PG8_SCHED;
            PG8_LDB(B0, 1, 0); PG8_LDB(B1, 1, 1); PG8_SCHED; PG8_LDA(At, 1, 0); PG8_STAGE(PG8_SA(0, 1), a2 + hstep, voffA);
            PG8_WAIT_V(8); PG8_WAIT_L(0); PG8_BAR; PG8_MMA(0, 0, At, B0); PG8_MMA(0, 1, At, B1); PG8_BAR; PG8_SCHED;
            PG8_LDA(At, 1, 1); PG8_STAGE(PG8_SB(1, 0), b3, voffB); PG8_STAGE(PG8_SB(1, 1), b3 + hstep, voffB); PG8_STAGE(PG8_SA(1, 0), a3, voffA);
            PG8_WAIT_V(8); PG8_WAIT_L(0); PG8_BAR; PG8_MMA(1, 0, At, B0); PG8_MMA(1, 1, At, B1); PG8_BAR; PG8_SCHED;
            } else {
            PG8_LDB(B0, 0, 0); PG8_SCHED; PG8_LDA(At, 0, 0); PG8_STAGE(PG8_SA(1, 1), a1 + hstep, voffA);
            PG8_WAIT_L(8); PG8_BAR; PG8_WAIT_L(0); PG8_MMA(0, 0, At, B0); PG8_BAR; PG8_SCHED;
            PG8_LDB(B1, 0, 1); PG8_STAGE(PG8_SB(0, 0), b2, voffB);
            PG8_BAR; PG8_WAIT_L(0); PG8_MMA(0, 1, At, B1); PG8_BAR;
            PG8_LDA(At, 0, 1); PG8_STAGE(PG8_SA(0, 0), a2, voffA);
            PG8_BAR; PG8_WAIT_L(0); PG8_MMA(1, 0, At, B0); PG8_BAR; PG8_SCHED;
            PG8_STAGE(PG8_SB(0, 1), b2 + hstep, voffB);
            PG8_WAIT_V(6); PG8_BAR; PG8_MMA(1, 1, At, B1); PG8_BAR;
            PG8_LDB(B0, 1, 0); PG8_SCHED; PG8_LDA(At, 1, 0); PG8_STAGE(PG8_SA(0, 1), a2 + hstep, voffA);
            PG8_WAIT_L(8); PG8_BAR; PG8_WAIT_L(0); PG8_MMA(0, 0, At, B0); PG8_BAR; PG8_SCHED;
            PG8_LDB(B1, 1, 1); PG8_STAGE(PG8_SB(1, 0), b3, voffB);
            PG8_BAR; PG8_WAIT_L(0); PG8_MMA(0, 1, At, B1); PG8_BAR;
            PG8_LDA(At, 1, 1); PG8_STAGE(PG8_SA(1, 0), a3, voffA);
            PG8_BAR; PG8_WAIT_L(0); PG8_MMA(1, 0, At, B0); PG8_BAR; PG8_SCHED;
            PG8_STAGE(PG8_SB(1, 1), b3 + hstep, voffB);
            PG8_WAIT_V(6); PG8_BAR; PG8_MMA(1, 1, At, B1); PG8_BAR;
            }
        }
        if constexpr (ALIGN_EPI) { if (wr == 0) PG8_BAR; }
        if constexpr (!Epi::AFTER_DRAIN) { E(acc, cur, wr, wc, fr, fq); S.done(cur); }
        if (!has_next) break;
#pragma unroll
        for (int a = 0; a < 2; ++a)
#pragma unroll
            for (int b = 0; b < 2; ++b)
#pragma unroll
                for (int m = 0; m < 4; ++m)
#pragma unroll
                    for (int n = 0; n < 2; ++n) acc[a][b][m][n] = (f32x4){0.f, 0.f, 0.f, 0.f};
        cur = nxt; cA = nA; cB = nB; ++ui;
        if constexpr (ALIGN_EPI) { if (wr == 1) PG8_BAR; }
    }
    PG8_WAIT_V(0);
    if constexpr (!ALIGN_EPI) { if (wr == 0) PG8_BAR; }
    PG8_BAR;
    if constexpr (Epi::AFTER_DRAIN) { E.fused(acc, cur, wr, wc, fr, fq, lds, wid, lane); S.done(cur); }
#undef PG8_SA
#undef PG8_SB
#undef PG8_STAGE
#undef PG8_LDA
#undef PG8_LDB
#undef PG8_MMA
#undef PG8_WAIT_V
#undef PG8_WAIT_L
#undef PG8_BAR
#undef PG8_SCHED
}
}

#define LAS __attribute__((address_space(3)))
typedef unsigned short bf16;
typedef short bf16x8 __attribute__((ext_vector_type(8)));
typedef float f32x4 __attribute__((ext_vector_type(4)));
typedef float f32x16 __attribute__((ext_vector_type(16)));
typedef unsigned u32x4 __attribute__((ext_vector_type(4)));
typedef unsigned u32x2 __attribute__((ext_vector_type(2)));
typedef float f32x2_t __attribute__((ext_vector_type(2)));
typedef __bf16 bf16x2_t __attribute__((ext_vector_type(2)));
using pg8::Unit;

constexpr int M = 32768, SEQ = 8192, DM = 1024, FF = 2816, NGU = 5632;
constexpr float EPS = 1e-6f;
constexpr float LOG2E = 1.4426950408889634f;
constexpr size_t MiB = (size_t)1 << 20;
constexpr size_t WS_COSM = 0, WS_SINM = 1 * MiB, WS_COSD = 2 * MiB, WS_SIND = 2 * MiB + 256 * 1024;
constexpr size_t WS_S5A = 2 * MiB + 512 * 1024, WS_S5A64 = WS_S5A + 64 * 1024, WS_S5BB = 3 * MiB, WS_S5CT = 3 * MiB + 512 * 1024, WS_LAM = 4 * MiB;
constexpr size_t WS_W = 8 * MiB, WS_XN = 170 * MiB, WS_R1 = 234 * MiB, WS_NEED = 496 * MiB;
constexpr size_t W_FFN_L = 17301504, W_GU1 = 0, W_D1 = 5767168, W_GU2 = 8650752, W_D2 = 14417920;
constexpr size_t W_EVEN0 = 69206016, W_EVEN_L = 3538944, W_WIN = 0, W_QUP = 1572864, W_KVUP = 1966080, W_GLU = 2228224, W_WOUT = 2490368;
constexpr size_t W_ODD0 = W_EVEN0 + 2 * W_EVEN_L, W_ODD_L = 4194304, W_DIN = 0, W_DOUT = 3145728;
constexpr size_t R_H = 0;
constexpr size_t R_ZA = 0, R_Q = 0, R_KN = 48 * MiB, R_VT = 80 * MiB, R_U = 112 * MiB, R_ZQN = 176 * MiB, R_YGB = 176 * MiB, R_ZKVN = 208 * MiB, R_KPE = 224 * MiB,
                 R_SLOC = 228 * MiB, R_CARRY = 244 * MiB;
constexpr size_t R_QD = 0, R_KD = 64 * MiB, R_VTD = 128 * MiB;
constexpr int ZA_LD = 832, ZN = 1536;

__device__ __forceinline__ unsigned pk2(float lo, float hi) { f32x2_t v = {lo, hi}; bf16x2_t b = __builtin_convertvector(v, bf16x2_t); return __builtin_bit_cast(unsigned, b); }
__device__ __forceinline__ bf16x8 pack8(f32x4 a, f32x4 b) { u32x4 w = {pk2(a[0], a[1]), pk2(a[2], a[3]), pk2(b[0], b[1]), pk2(b[2], b[3])}; return __builtin_bit_cast(bf16x8, w); }
__device__ __forceinline__ float bf2f(unsigned short v) { return __uint_as_float((unsigned)v << 16); }
__device__ __forceinline__ float xor32_max(float v) { auto rr = __builtin_amdgcn_permlane32_swap(__float_as_uint(v), __float_as_uint(v), false, false); return fmaxf(__uint_as_float(rr[0]), __uint_as_float(rr[1])); }
__device__ __forceinline__ float xor32_add(float v) { auto rr = __builtin_amdgcn_permlane32_swap(__float_as_uint(v), __float_as_uint(v), false, false); return __uint_as_float(rr[0]) + __uint_as_float(rr[1]); }
#define SWZ_XOR(v, m) __int_as_float(__builtin_amdgcn_ds_swizzle(__float_as_int(v), 0x1f | ((m) << 10)))
__device__ __forceinline__ float wave_sum(float v) {
    v += SWZ_XOR(v, 1); v += SWZ_XOR(v, 2); v += SWZ_XOR(v, 4); v += SWZ_XOR(v, 8); v += SWZ_XOR(v, 16);
    return xor32_add(v);
}
__device__ __forceinline__ float sigmoidf_(float v) { return __builtin_amdgcn_rcpf(1.0f + __builtin_amdgcn_exp2f(v * -1.4426950408889634f)); }
#define MFMA32(a, b, c) __builtin_amdgcn_mfma_f32_32x32x16_bf16((a), (b), (c), 0, 0, 0)
#define MFMA16(a, b, c) __builtin_amdgcn_mfma_f32_16x16x32_bf16((a), (b), (c), 0, 0, 0)

#define EPI_LOOP_BEGIN \
    _Pragma("unroll") for (int ai = 0; ai < 2; ++ai) _Pragma("unroll") for (int m = 0; m < 4; ++m) _Pragma("unroll") for (int bj = 0; bj < 2; ++bj) { \
        const int row = u.pm * 256 + ai * 128 + wr * 64 + m * 16 + fr; const int col0 = u.pn * 256 + bj * 128 + wc * 32 + 8 * fq; \
        const f32x4 v0 = acc[ai][bj][m][0], v1 = acc[ai][bj][m][1]; (void)row; (void)col0;
#define EPI_LOOP_END }

struct EpiSwiglu {
    static constexpr bool PERM = true, AFTER_DRAIN = false;
    bf16* H;
    __device__ __forceinline__ void operator()(const f32x4 (&acc)[2][2][4][2], const Unit& u, int wr, int wc, int fr, int fq) const {
#pragma unroll
        for (int ai = 0; ai < 2; ++ai)
#pragma unroll
            for (int m = 0; m < 4; ++m) {
                const int row = u.pm * 256 + ai * 128 + wr * 64 + m * 16 + fr, f0 = u.pn * 128 + wc * 32 + 8 * fq;
                const f32x4 g0 = acc[ai][0][m][0], g1 = acc[ai][0][m][1], u0 = acc[ai][1][m][0], u1 = acc[ai][1][m][1];
                f32x4 o0, o1;
#pragma unroll
                for (int e = 0; e < 4; ++e) { o0[e] = g0[e] * sigmoidf_(g0[e]) * u0[e]; o1[e] = g1[e] * sigmoidf_(g1[e]) * u1[e]; }
                *(bf16x8*)(H + (size_t)row * FF + f0) = pack8(o0, o1);
            }
    }
};
struct EpiResid {
    static constexpr bool PERM = true, AFTER_DRAIN = false;
    const float* src; float* dst;
    __device__ __forceinline__ void operator()(const f32x4 (&acc)[2][2][4][2], const Unit& u, int wr, int wc, int fr, int fq) const {
        EPI_LOOP_BEGIN
            const size_t off = (size_t)row * DM + col0;
            const f32x4 a = *(const f32x4*)(src + off), b = *(const f32x4*)(src + off + 4);
            *(f32x4*)(dst + off) = a + v0; *(f32x4*)(dst + off + 4) = b + v1;
        EPI_LOOP_END
    }
};
struct EpiZ {
    static constexpr bool PERM = true, AFTER_DRAIN = false;
    float* ZA; float* U;
    __device__ __forceinline__ void operator()(const f32x4 (&acc)[2][2][4][2], const Unit& u, int wr, int wc, int fr, int fq) const {
        EPI_LOOP_BEGIN
            if (col0 < 832) { float* p = ZA + (size_t)row * ZA_LD + col0; *(f32x4*)p = v0; *(f32x4*)(p + 4) = v1; }
            else if (col0 < 1344) { float* p = U + (size_t)row * 512 + (col0 - 832); *(f32x4*)p = v0; *(f32x4*)(p + 4) = v1; }
        EPI_LOOP_END
    }
};
struct EpiQ {
    static constexpr bool PERM = true, AFTER_DRAIN = false;
    bf16* Q; const float* cosm; const float* sinm; float qs;
    __device__ __forceinline__ void operator()(const f32x4 (&acc)[2][2][4][2], const Unit& u, int wr, int wc, int fr, int fq) const {
        EPI_LOOP_BEGIN
            f32x4 a = v0, b = v1;
            const int hq = col0 / 192, d = col0 - hq * 192;
            if (d >= 128) {
                const int t0 = (d - 128) >> 1; const int pos = row & (SEQ - 1);
                const f32x4 c = *(const f32x4*)(cosm + pos * 32 + t0), s = *(const f32x4*)(sinm + pos * 32 + t0);
                a = (f32x4){v0[0] * c[0] - v0[1] * s[0], v0[1] * c[0] + v0[0] * s[0], v0[2] * c[1] - v0[3] * s[1], v0[3] * c[1] + v0[2] * s[1]};
                b = (f32x4){v1[0] * c[2] - v1[1] * s[2], v1[1] * c[2] + v1[0] * s[2], v1[2] * c[3] - v1[3] * s[3], v1[3] * c[3] + v1[2] * s[3]};
            }
            a = a * qs; b = b * qs;
            *(bf16x8*)(Q + (size_t)row * 768 + col0) = pack8(a, b);
        EPI_LOOP_END
    }
};
struct EpiKV {
    static constexpr bool PERM = true, AFTER_DRAIN = false;
    bf16* KN; bf16* VT;
    __device__ __forceinline__ void operator()(const f32x4 (&acc)[2][2][4][2], const Unit& u, int wr, int wc, int fr, int fq) const {
        EPI_LOOP_BEGIN
            const int hq = u.pn, dl = wc * 32 + 8 * fq;
            if (bj == 0) { *(bf16x8*)(KN + (size_t)row * 512 + hq * 128 + dl) = pack8(v0, v1); }
            else {
                const int b = row >> 13, s0_ = row & (SEQ - 1), s = (s0_ & ~15) | (((s0_ >> 2) & 1) << 3) | (((s0_ >> 3) & 1) << 2) | (s0_ & 3);
                bf16* p = VT + ((size_t)((b * 4 + hq) * 128 + dl)) * SEQ + s;
                const bf16x8 w = pack8(v0, v1);
#pragma unroll
                for (int e = 0; e < 8; ++e) p[(size_t)e * SEQ] = (bf16)w[e];
            }
        EPI_LOOP_END
    }
};
struct EpiDiffIn {
    static constexpr bool PERM = true, AFTER_DRAIN = false;
    bf16* QD; bf16* KD; bf16* VT; const float* cosd; const float* sind; float qs;
    __device__ __forceinline__ void operator()(const f32x4 (&acc)[2][2][4][2], const Unit& u, int wr, int wc, int fr, int fq) const {
        EPI_LOOP_BEGIN
            if (col0 < 2048) {
                f32x4 a = v0, b = v1;
                const int d = col0 & 63;
                if (d < 16) {
                    const int t0 = d >> 1; const int pos = row & (SEQ - 1);
                    const f32x4 c = *(const f32x4*)(cosd + pos * 8 + t0), s = *(const f32x4*)(sind + pos * 8 + t0);
                    a = (f32x4){v0[0] * c[0] - v0[1] * s[0], v0[1] * c[0] + v0[0] * s[0], v0[2] * c[1] - v0[3] * s[1], v0[3] * c[1] + v0[2] * s[1]};
                    b = (f32x4){v1[0] * c[2] - v1[1] * s[2], v1[1] * c[2] + v1[0] * s[2], v1[2] * c[3] - v1[3] * s[3], v1[3] * c[3] + v1[2] * s[3]};
                }
                if (col0 < 1024) { a = a * qs; b = b * qs; *(bf16x8*)(QD + (size_t)row * 1024 + col0) = pack8(a, b); }
                else { *(bf16x8*)(KD + (size_t)row * 1024 + (col0 - 1024)) = pack8(a, b); }
            } else {
                const int hv = (col0 - 2048) >> 7, dl = col0 & 127;
                const int b = row >> 13, s0_ = row & (SEQ - 1), s = (s0_ & ~15) | (((s0_ >> 2) & 1) << 3) | (((s0_ >> 3) & 1) << 2) | (s0_ & 3);
                bf16* p = VT + ((size_t)((b * 8 + hv) * 128 + dl)) * SEQ + s;
                const bf16x8 w = pack8(v0, v1);
#pragma unroll
                for (int e = 0; e < 8; ++e) p[(size_t)e * SEQ] = (bf16)w[e];
            }
        EPI_LOOP_END
    }
};
struct EpiGlu {
    static constexpr bool PERM = true, AFTER_DRAIN = false;
    const bf16* YG; const float* bias; bf16* CAT;
    __device__ __forceinline__ void operator()(const f32x4 (&acc)[2][2][4][2], const Unit& u, int wr, int wc, int fr, int fq) const {
        EPI_LOOP_BEGIN
            const f32x4 b0 = *(const f32x4*)(bias + col0), b1 = *(const f32x4*)(bias + col0 + 4);
            const bf16x8 y = *(const bf16x8*)(YG + (size_t)row * 512 + col0);
            f32x4 o0, o1;
#pragma unroll
            for (int e = 0; e < 4; ++e) { o0[e] = bf2f((unsigned short)y[e]) * sigmoidf_(v0[e] + b0[e]); o1[e] = bf2f((unsigned short)y[4 + e]) * sigmoidf_(v1[e] + b1[e]); }
            *(bf16x8*)(CAT + (size_t)row * DM + 512 + col0) = pack8(o0, o1);
        EPI_LOOP_END
    }
};

__device__ __forceinline__ void prep_w(const float* W, int K, int N, bf16* dst, int mode, int omul, int oadd, const float* gain, int gmask, float scale, int gw, int NGW, int lane, LAS float* scr) {
    const int nkb = K >> 6, nnb = N >> 5, nitems = nkb * nnb;
    const int hl = lane >> 5, l31 = lane & 31, c = lane & 7, r8 = lane >> 3;
    for (int it = gw; it < nitems; it += NGW) {
        const int kb = it / nnb, nb = it - kb * nnb, k0 = kb * 64, n0 = nb * 32;
        const float* src = W + (size_t)(k0 + hl) * N + n0 + l31;
        float v[32];
#pragma unroll
        for (int i = 0; i < 32; ++i) v[i] = src[(size_t)(2 * i) * N];
#pragma unroll
        for (int i = 0; i < 32; ++i) { const int k = k0 + 2 * i + hl; const float g = gain ? gain[k & gmask] * scale : scale; scr[(2 * i + hl) * 33 + l31] = v[i] * g; }
        asm volatile("s_waitcnt lgkmcnt(0)" ::: "memory");
#pragma unroll
        for (int j = 0; j < 4; ++j) {
            const int nl = r8 + 8 * j, n = n0 + nl;
            int nd = n;
            if (mode == 2) { const int hq = n / 192; int d = n - hq * 192; if (d >= 128) { const int dd = d - 128; d = 128 + 2 * (dd & 31) + (dd >> 5); } nd = hq * 192 + d; }
            else if (mode == 3) { if (n < 2048) { int d = n & 63; if (d < 16) d = 2 * (d & 7) + (d >> 3); nd = (n & ~63) + d; } }
            if (mode == 4) nd = (n >> 7) * 256 + (n & 127) + oadd; else nd = nd * omul + oadd;
            const LAS float* sp = scr + (8 * c) * 33 + nl;
            const f32x4 a = {sp[0], sp[33], sp[66], sp[99]}, b = {sp[132], sp[165], sp[198], sp[231]};
            *(bf16x8*)(dst + (size_t)nd * K + k0 + 8 * c) = pack8(a, b);
        }
        asm volatile("s_waitcnt lgkmcnt(0)" ::: "memory");
    }
}

__device__ __forceinline__ void norm_rows(const float* x, bf16* xn, int gw, int NGW, int lane) {
    for (int row = gw; row < M; row += 2 * NGW) {
        const int row2 = row + NGW; const bool has2 = row2 < M;
        const f32x4* xr = (const f32x4*)(x + (size_t)row * DM) + lane;
        const f32x4* xr2 = (const f32x4*)(x + (size_t)(has2 ? row2 : row) * DM) + lane;
        f32x4 v[4], w[4]; float s = 0.f, s2 = 0.f;
#pragma unroll
        for (int j = 0; j < 4; ++j) { v[j] = xr[64 * j]; w[j] = xr2[64 * j]; }
#pragma unroll
        for (int j = 0; j < 4; ++j) { s += (v[j][0] * v[j][0] + v[j][1] * v[j][1]) + (v[j][2] * v[j][2] + v[j][3] * v[j][3]); s2 += (w[j][0] * w[j][0] + w[j][1] * w[j][1]) + (w[j][2] * w[j][2] + w[j][3] * w[j][3]); }
        const float rstd = rsqrtf(wave_sum(s) * (1.f / DM) + EPS), rstd2 = rsqrtf(wave_sum(s2) * (1.f / DM) + EPS);
        u32x2* o = (u32x2*)(xn + (size_t)row * DM) + lane;
#pragma unroll
        for (int j = 0; j < 4; ++j) o[64 * j] = (u32x2){pk2(v[j][0] * rstd, v[j][1] * rstd), pk2(v[j][2] * rstd, v[j][3] * rstd)};
        if (has2) {
            u32x2* o2 = (u32x2*)(xn + (size_t)row2 * DM) + lane;
#pragma unroll
            for (int j = 0; j < 4; ++j) o2[64 * j] = (u32x2){pk2(w[j][0] * rstd2, w[j][1] * rstd2), pk2(w[j][2] * rstd2, w[j][3] * rstd2)};
        }
    }
}
__device__ __forceinline__ void final_norm_rows(float* x, const float* gain, int gw, int NGW, int lane) {
    for (int row = gw; row < M; row += 2 * NGW) {
        const int row2 = (row + NGW < M) ? row + NGW : row;
        f32x4* xr = (f32x4*)(x + (size_t)row * DM) + lane; f32x4* xr2 = (f32x4*)(x + (size_t)row2 * DM) + lane;
        f32x4 v[4], w[4]; float s = 0.f, s2 = 0.f;
#pragma unroll
        for (int j = 0; j < 4; ++j) { v[j] = xr[64 * j]; w[j] = xr2[64 * j]; }
#pragma unroll
        for (int j = 0; j < 4; ++j) { s += (v[j][0] * v[j][0] + v[j][1] * v[j][1]) + (v[j][2] * v[j][2] + v[j][3] * v[j][3]); s2 += (w[j][0] * w[j][0] + w[j][1] * w[j][1]) + (w[j][2] * w[j][2] + w[j][3] * w[j][3]); }
        const float rstd = rsqrtf(wave_sum(s) * (1.f / DM) + EPS), rstd2 = rsqrtf(wave_sum(s2) * (1.f / DM) + EPS);
#pragma unroll
        for (int j = 0; j < 4; ++j) { const f32x4 g = ((const f32x4*)gain)[lane + 64 * j]; xr[64 * j] = v[j] * rstd * g; if (row2 != row) xr2[64 * j] = w[j] * rstd2 * g; }
    }
}
__device__ __forceinline__ void post_rows(const float* ZA, bf16* ZQN, bf16* ZKVN, bf16* KPE, const float* cosm, const float* sinm, int gw, int NGW, int lane) {
    for (int row = gw; row < M; row += NGW) {
        const float* za = ZA + (size_t)row * ZA_LD;
        const f32x4 a0 = ((const f32x4*)za)[lane], a1 = ((const f32x4*)za)[64 + lane], kv = ((const f32x4*)(za + 512))[lane];
        float sq = (a0[0] * a0[0] + a0[1] * a0[1]) + (a0[2] * a0[2] + a0[3] * a0[3]) + (a1[0] * a1[0] + a1[1] * a1[1]) + (a1[2] * a1[2] + a1[3] * a1[3]);
        float sk = (kv[0] * kv[0] + kv[1] * kv[1]) + (kv[2] * kv[2] + kv[3] * kv[3]);
        const float rq = rsqrtf(wave_sum(sq) * (1.f / 512.f) + EPS), rk = rsqrtf(wave_sum(sk) * (1.f / 256.f) + EPS);
        u32x2* oq = (u32x2*)(ZQN + (size_t)row * 512);
        oq[lane] = (u32x2){pk2(a0[0] * rq, a0[1] * rq), pk2(a0[2] * rq, a0[3] * rq)};
        oq[64 + lane] = (u32x2){pk2(a1[0] * rq, a1[1] * rq), pk2(a1[2] * rq, a1[3] * rq)};
        ((u32x2*)(ZKVN + (size_t)row * 256))[lane] = (u32x2){pk2(kv[0] * rk, kv[1] * rk), pk2(kv[2] * rk, kv[3] * rk)};
        if (lane < 32) {
            const float x1 = za[768 + lane], x2 = za[800 + lane]; const int pos = row & (SEQ - 1);
            const float c = cosm[pos * 32 + lane], s = sinm[pos * 32 + lane];
            ((unsigned*)(KPE + (size_t)row * 64))[lane] = pk2(x1 * c - x2 * s, x2 * c + x1 * s);
        }
    }
}

template <bool PC>
__device__ __forceinline__ void s5_pass(LAS unsigned char* xl  , const float* U, const float2* Atab, const bf16* BB, const bf16* CT,
                                        float2* SLOC, const float2* CARRY, const float* dvec, bf16* YGb, int gw, int NGW, int lane) {
    const int col = lane & 31, hi = lane >> 5;
    const int aseq = (col >> 2) & 1, ai_ = (col & 3) + 4 * (col >> 3);
    const int c16 = lane & 15, quad = lane >> 4;
    for (int u = gw; u < 8192; u += NGW) {
        const int g = u & 31, bp = (u >> 5) & 1, ch = u >> 6;
        const int b0 = bp * 2, t0 = ch * 64;
        bf16x8 ua[4];
#pragma unroll
        for (int blk = 0; blk < 4; ++blk) {
            const float* p = U + ((size_t)((b0 + aseq) * SEQ + t0 + 16 * blk + ai_)) * 512 + g * 16 + 8 * hi;
            ua[blk] = pack8(*(const f32x4*)p, *(const f32x4*)(p + 4));
        }
        f32x4 acc[2][4];
#pragma unroll
        for (int s = 0; s < 2; ++s)
#pragma unroll
            for (int b = 0; b < 4; ++b) acc[s][b] = (f32x4){0.f, 0.f, 0.f, 0.f};
#pragma unroll
        for (int dir = 0; dir < 2; ++dir) {
            const int tb = dir * 32 + g;
            bf16x8 bbf[4];
#pragma unroll
            for (int q = 0; q < 4; ++q) bbf[q] = *(const bf16x8*)(BB + ((size_t)tb * 128 + q * 32 + col) * 16 + 8 * hi);
            const float2 a0 = Atab[tb * 64 + col], a1 = Atab[tb * 64 + col + 32];
            const size_t sidx = ((size_t)((dir * 4 + b0 + hi) * 32 + g) * 128 + ch) * 64;
            float xr0 = 0.f, xi0 = 0.f, xr1 = 0.f, xi1 = 0.f;
            bf16x8 ctf[4];
            if (PC) {
                const float2 c0 = CARRY[sidx + col], c1 = CARRY[sidx + col + 32];
                xr0 = c0.x; xi0 = c0.y; xr1 = c1.x; xi1 = c1.y;
#pragma unroll
                for (int kq = 0; kq < 4; ++kq) ctf[kq] = *(const bf16x8*)(CT + ((size_t)tb * 16 + c16) * 128 + 32 * kq + 8 * quad);
            }
#pragma unroll
            for (int bb = 0; bb < 4; ++bb) {
                const int blk = dir ? 3 - bb : bb;
                f32x16 bu[4];
                const f32x16 zero = {0.f, 0.f, 0.f, 0.f, 0.f, 0.f, 0.f, 0.f, 0.f, 0.f, 0.f, 0.f, 0.f, 0.f, 0.f, 0.f};
#pragma unroll
                for (int q = 0; q < 4; ++q) bu[q] = MFMA32(ua[blk], bbf[q], zero);
#pragma unroll
                for (int ii = 0; ii < 16; ++ii) {
                    const int i = dir ? 15 - ii : ii;
                    const float nr0 = a0.x * xr0 - a0.y * xi0 + bu[0][i], ni0 = a0.x * xi0 + a0.y * xr0 + bu[1][i];
                    const float nr1 = a1.x * xr1 - a1.y * xi1 + bu[2][i], ni1 = a1.x * xi1 + a1.y * xr1 + bu[3][i];
                    xr0 = nr0; xi0 = ni0; xr1 = nr1; xi1 = ni1;
                    if (PC) *(LAS u32x2*)(xl + (16 * hi + i) * 272 + col * 8) = (u32x2){pk2(xr0, xi0), pk2(xr1, xi1)};
                }
                if (PC) {
#pragma unroll
                    for (int s = 0; s < 2; ++s)
#pragma unroll
                        for (int kq = 0; kq < 4; ++kq) {
                            const bf16x8 xa = *(const LAS bf16x8*)(xl + (16 * s + c16) * 272 + (32 * kq + 8 * quad) * 2);
                            acc[s][blk] = MFMA16(xa, ctf[kq], acc[s][blk]);
                        }
                }
            }
            if (!PC) { SLOC[sidx + col] = make_float2(xr0, xi0); SLOC[sidx + col + 32] = make_float2(xr1, xi1); }
        }
        if (PC) {
            const int cc = g * 16 + c16; const float dv = dvec[cc];
#pragma unroll
            for (int s = 0; s < 2; ++s)
#pragma unroll
                for (int blk = 0; blk < 4; ++blk)
#pragma unroll
                    for (int j = 0; j < 4; ++j) {
                        const size_t row = (size_t)(b0 + s) * SEQ + t0 + 16 * blk + 4 * quad + j;
                        float y = acc[s][blk][j] + dv * U[row * 512 + cc];
                        const float z2 = 1.5957691216f * (y + 0.044715f * y * y * y);
                        y = y * __builtin_amdgcn_rcpf(1.0f + __builtin_amdgcn_exp2f(z2 * -1.4426950408889634f));
                        YGb[row * 512 + cc] = (bf16)(pk2(y, 0.f) & 0xffffu);
                    }
        }
    }
}
__device__ __forceinline__ void s5_passB(const float2* A64, const float2* SLOC, float2* CARRY) {
    int tid_ = threadIdx.x; asm volatile("" : "+v"(tid_));
    if (tid_ >= 64) return;
    for (int idx = blockIdx.x * 64 + tid_; idx < 16384; idx += gridDim.x * 64) {
        const int dir = idx >> 13, rest = idx & 8191, b = rest >> 11, g = (rest >> 6) & 31, p = rest & 63;
        const float2 a = A64[(dir * 32 + g) * 64 + p];
        const size_t base = ((size_t)((dir * 4 + b) * 32 + g) * 128) * 64 + p;
        float cr = 0.f, ci = 0.f;
#pragma unroll 1
        for (int kk0 = 0; kk0 < 128; kk0 += 32) {
            float2 sv[32];
#pragma unroll
            for (int j = 0; j < 32; ++j) { const int k = dir ? 127 - (kk0 + j) : kk0 + j; sv[j] = SLOC[base + (size_t)k * 64]; }
#pragma unroll
            for (int j = 0; j < 32; ++j) {
                const int k = dir ? 127 - (kk0 + j) : kk0 + j;
                CARRY[base + (size_t)k * 64] = make_float2(cr, ci);
                const float nr = a.x * cr - a.y * ci + sv[j].x, ni = a.x * ci + a.y * cr + sv[j].y;
                cr = nr; ci = ni;
            }
        }
    }
}

__device__ __forceinline__ void glds16(const void* gsrc, unsigned lds_dst) {
    unsigned keep;
    asm volatile("s_mov_b32 %0, m0\n\ts_mov_b32 m0, %2\n\ts_nop 0\n\tglobal_load_lds_dwordx4 %1, off\n\ts_mov_b32 m0, %0" : "=&s"(keep) : "v"(gsrc), "s"(lds_dst) : "memory");
}
template <int MODE>
__device__ __forceinline__ void att_qk(f32x16& s0, f32x16& s1, const LAS unsigned char* kslot, int ka, const bf16x8 (&qf)[MODE == 0 ? 12 : 4]) {
    constexpr int NKS = MODE == 0 ? 12 : 4, RB = MODE == 0 ? 384 : 256;
    f32x16 z;
#pragma unroll
    for (int i = 0; i < 16; ++i) z[i] = 0.f;
#pragma unroll
    for (int ks = 0; ks < NKS; ++ks) {
        const LAS unsigned char* p = kslot + ((ka ^ ((ks & 3) * 32)) + (ks >> 2) * 128);
        const bf16x8 a0 = *(const LAS bf16x8*)p, a1 = *(const LAS bf16x8*)(p + 32 * RB);
        if (ks == 0) { s0 = MFMA32(a0, qf[0], z); s1 = MFMA32(a1, qf[0], z); }
        else { s0 = MFMA32(a0, qf[ks], s0); s1 = MFMA32(a1, qf[ks], s1); }
    }
}
__device__ __forceinline__ float att_rowmax(const f32x16& s0, const f32x16& s1) {
    float a = fmaxf(fmaxf(s0[0], s0[1]), s1[0]), b = fmaxf(fmaxf(s0[2], s0[3]), s1[1]);
    a = fmaxf(fmaxf(a, s1[2]), s1[3]);
#pragma unroll
    for (int i = 4; i < 16; i += 4) { a = fmaxf(fmaxf(a, s0[i]), s0[i + 1]); b = fmaxf(fmaxf(b, s0[i + 2]), s0[i + 3]); a = fmaxf(fmaxf(a, s1[i]), s1[i + 1]); b = fmaxf(fmaxf(b, s1[i + 2]), s1[i + 3]); }
    return xor32_max(fmaxf(a, b));
}
__device__ __forceinline__ void att_exp(f32x16& s0, f32x16& s1, float mhat, float& lrun, bf16x8 (&pf)[4]) {
    float p0 = 0.f, p1 = 0.f;
#pragma unroll
    for (int i = 0; i < 16; ++i) { s0[i] = __builtin_amdgcn_exp2f(s0[i] - mhat); s1[i] = __builtin_amdgcn_exp2f(s1[i] - mhat); p0 += s0[i]; p1 += s1[i]; }
    lrun += p0 + p1;
    pf[0] = pack8((f32x4){s0[0], s0[1], s0[2], s0[3]}, (f32x4){s0[4], s0[5], s0[6], s0[7]});
    pf[1] = pack8((f32x4){s0[8], s0[9], s0[10], s0[11]}, (f32x4){s0[12], s0[13], s0[14], s0[15]});
    pf[2] = pack8((f32x4){s1[0], s1[1], s1[2], s1[3]}, (f32x4){s1[4], s1[5], s1[6], s1[7]});
    pf[3] = pack8((f32x4){s1[8], s1[9], s1[10], s1[11]}, (f32x4){s1[12], s1[13], s1[14], s1[15]});
}
__device__ __forceinline__ void att_pv(f32x16 (&o)[4], const LAS unsigned char* vslot, int va, const bf16x8 (&pf)[4]) {
#pragma unroll
    for (int db = 0; db < 4; ++db)
#pragma unroll
        for (int kk = 0; kk < 4; ++kk) {
            const bf16x8 v = *(const LAS bf16x8*)(vslot + ((va ^ (kk * 32)) + db * 4096));
            o[db] = MFMA32(v, pf[kk], o[db]);
        }
}

__device__ __forceinline__ void att1_load(bf16x8 (&kf)[8], bf16x8 (&vf)[8], const LAS unsigned char* kslot, int ka, const LAS unsigned char* vslot, int va) {
#pragma unroll
    for (int ks = 0; ks < 4; ++ks) { const LAS unsigned char* p = kslot + (ka ^ (ks * 32)); kf[2 * ks] = *(const LAS bf16x8*)p; kf[2 * ks + 1] = *(const LAS bf16x8*)(p + 32 * 256); }
#pragma unroll
    for (int kk = 0; kk < 2; ++kk)
#pragma unroll
        for (int db = 0; db < 4; ++db) vf[kk * 4 + db] = *(const LAS bf16x8*)(vslot + ((va ^ (kk * 32)) + db * 4096));
}
__device__ __forceinline__ void att1_load2(bf16x8 (&vg)[8], const LAS unsigned char* vslot, int va) {
#pragma unroll
    for (int kk = 2; kk < 4; ++kk)
#pragma unroll
        for (int db = 0; db < 4; ++db) vg[(kk - 2) * 4 + db] = *(const LAS bf16x8*)(vslot + ((va ^ (kk * 32)) + db * 4096));
}
__device__ __forceinline__ void att1_qk(f32x16& s0, f32x16& s1, const bf16x8 (&kf)[8], const bf16x8 (&qf)[4]) {
    f32x16 z;
#pragma unroll
    for (int i = 0; i < 16; ++i) z[i] = 0.f;
    s0 = MFMA32(kf[0], qf[0], z); s1 = MFMA32(kf[1], qf[0], z);
#pragma unroll
    for (int ks = 1; ks < 4; ++ks) { s0 = MFMA32(kf[2 * ks], qf[ks], s0); s1 = MFMA32(kf[2 * ks + 1], qf[ks], s1); }
}
__device__ __forceinline__ void att1_pv(f32x16 (&o)[4], const bf16x8 (&vf)[8], const bf16x8 (&vg)[8], const bf16x8 (&pf)[4]) {
#pragma unroll
    for (int kk = 0; kk < 2; ++kk)
#pragma unroll
        for (int db = 0; db < 4; ++db) o[db] = MFMA32(vf[kk * 4 + db], pf[kk], o[db]);
#pragma unroll
    for (int kk = 2; kk < 4; ++kk)
#pragma unroll
        for (int db = 0; db < 4; ++db) o[db] = MFMA32(vg[(kk - 2) * 4 + db], pf[kk], o[db]);
}
template <int MODE>
__device__ __forceinline__ void attn_phase(LAS unsigned char* lds, const bf16* Qp, const bf16* Kp, const bf16* KPEp, const bf16* Vtp, bf16* CAT, float lam, int vcu, int G) {
    constexpr int NKS = MODE == 0 ? 12 : 4;
    constexpr int RB = MODE == 0 ? 384 : 256;
    constexpr int KB = 64 * RB, VB = 128 * 128;
    constexpr int NKI = MODE == 0 ? 3 : 2;
    constexpr int NUNITS = MODE == 0 ? 512 : 2048;
    constexpr float THR = 8.f;
    const unsigned lds0 = (unsigned)(uintptr_t)lds;
    for (int unit = vcu; unit < NUNITS; unit += G) {
        int tid_ = threadIdx.x; asm volatile("" : "+v"(tid_)); const int tid = tid_, lane = tid & 63, wave = __builtin_amdgcn_readfirstlane(tid >> 6), r = lane & 31, hh = lane >> 5;
        int b, h, q0, wq, map, bh;
        if (MODE == 0) { const int qb = unit & 31; bh = unit >> 5; b = bh >> 2; h = bh & 3; q0 = qb * 256; wq = wave; map = 0; }
        else { const int qb = unit & 63; bh = unit >> 6; b = bh >> 3; h = bh & 7; q0 = qb * 128; wq = wave & 3; map = wave >> 2; }
        const size_t rowbase = (size_t)b * SEQ;
        const size_t qrow = rowbase + q0 + 32 * wq + r;
        bf16x8 qf[NKS];
        {
            const bf16* qp = MODE == 0 ? Qp + qrow * 768 + h * 192 + 8 * hh : Qp + qrow * 1024 + (2 * h + map) * 64 + 8 * hh;
#pragma unroll
            for (int ks = 0; ks < NKS; ++ks) qf[ks] = *(const bf16x8*)(qp + 16 * ks);
        }
        const bf16* kp[NKI]; int kadv[NKI];
#pragma unroll
        for (int n = 0; n < NKI; ++n) {
            const int P = 64 * (wave + 8 * n) + lane;
            if (MODE == 0) {
                const int row = P / 24, cp = P - row * 24, c = (cp & ~7) | ((cp & 7) ^ ((row >> 1) & 7));
                if (c < 16) { kp[n] = Kp + (rowbase + row) * 512 + h * 128 + c * 8; kadv[n] = 64 * 512; }
                else { kp[n] = KPEp + (rowbase + row) * 64 + (c - 16) * 8; kadv[n] = 64 * 64; }
            } else {
                const int row = P >> 4, c = (P & 15) ^ (row & 15);
                kp[n] = Kp + (rowbase + row) * 1024 + h * 128 + c * 8; kadv[n] = 64 * 1024;
            }
        }
        const bf16* vp[2];
#pragma unroll
        for (int n = 0; n < 2; ++n) { const int P = 64 * (wave + 8 * n) + lane, dv = P >> 3, c = (P & 7) ^ ((dv >> 1) & 7); vp[n] = Vtp + ((size_t)(bh * 128 + dv)) * SEQ + c * 8; }
        const unsigned kdma = lds0 + wave * 1024, vdma = lds0 + 3 * KB + wave * 1024;
#define ATT_DMA_K(slotoff) do { _Pragma("unroll") for (int n = 0; n < NKI; ++n) glds16(kp[n], (unsigned)__builtin_amdgcn_readfirstlane(kdma + (slotoff) + n * 8192)); } while (0)
#define ATT_DMA_V(slotoff) do { _Pragma("unroll") for (int n = 0; n < 2; ++n) glds16(vp[n], (unsigned)__builtin_amdgcn_readfirstlane(vdma + (slotoff) + n * 8192)); } while (0)
#define ATT_ADV_K() do { _Pragma("unroll") for (int n = 0; n < NKI; ++n) kp[n] += kadv[n]; } while (0)
#define ATT_ADV_V() do { _Pragma("unroll") for (int n = 0; n < 2; ++n) vp[n] += 64; } while (0)
#define ATT_RESC_O() do { if (havepend) { _Pragma("unroll") for (int db = 0; db < 4; ++db) _Pragma("unroll") for (int i = 0; i < 16; ++i) o[db][i] *= fpend; havepend = false; } } while (0)
        const int ka = MODE == 0 ? r * RB + ((hh ^ ((r >> 1) & 7)) * 16) : r * RB + (((map * 8 + hh) ^ (r & 15)) * 16);
        const int va = r * 128 + ((hh ^ ((r >> 1) & 7)) * 16);
        const LAS unsigned char* vring = lds + 3 * KB;
        f32x16 o[4], S0, S1;
        bf16x8 pf[4];
#pragma unroll
        for (int db = 0; db < 4; ++db)
#pragma unroll
            for (int i = 0; i < 16; ++i) o[db][i] = 0.f;
        float mhat = 0.f, lrun = 0.f, fpend = 1.f; bool havepend = false;
        ATT_DMA_K(0); ATT_ADV_K(); ATT_DMA_K(KB); ATT_ADV_K(); ATT_DMA_V(0); ATT_ADV_V();
        asm volatile("s_waitcnt vmcnt(0) lgkmcnt(0)\n\ts_barrier" ::: "memory");
        int kr = 0, kw = 2 * KB, vr = 2 * VB, vw = VB;
        if constexpr (MODE == 1) {
            bf16x8 pfB[4];
            bf16x8 kf[8], vf[8], vg[8];
            float fp = 1.f; bool pend = false;
#define ATT1_ITER(PFP, PFN, I, DO_C) do { \
            const int i_ = (I); \
            att1_load(kf, vf, lds + kr, ka, vring + vr, va); \
            __builtin_amdgcn_sched_barrier(0); \
            att1_qk(S0, S1, kf, qf); \
            att1_load2(vg, vring + vr, va); \
            const float rm = att_rowmax(S0, S1); \
            if (!(DO_C)) mhat = rm; \
            else if (__any(rm - mhat > THR)) { const float dl = fmaxf(rm - mhat, 0.f); fp = __builtin_amdgcn_exp2f(-dl); lrun *= fp; mhat += dl; pend = true; } \
            if (DO_C) att1_pv(o, vf, vg, PFP); \
            att_exp(S0, S1, mhat, lrun, PFN); \
            if (DO_C) { _Pragma("unroll") for (int g_ = 0; g_ < 16; ++g_) { __builtin_amdgcn_sched_group_barrier(0x008, 1, 0); __builtin_amdgcn_sched_group_barrier(0x002, 7, 0); } } \
            if (pend) { _Pragma("unroll") for (int db = 0; db < 4; ++db) _Pragma("unroll") for (int e = 0; e < 16; ++e) o[db][e] *= fp; pend = false; } \
            ATT_DMA_K(kw); ATT_DMA_V(vw); \
            if (i_ + 2 < 127) ATT_ADV_K(); \
            if (i_ + 1 < 127) ATT_ADV_V(); \
            kr = (kr == 2 * KB) ? 0 : kr + KB; kw = (kw == 2 * KB) ? 0 : kw + KB; \
            vr = (vr == 2 * VB) ? 0 : vr + VB; vw = (vw == 2 * VB) ? 0 : vw + VB; \
            asm volatile("s_waitcnt vmcnt(4) lgkmcnt(0)\n\ts_barrier" ::: "memory"); } while (0)
            ATT1_ITER(pfB, pf, 0, false);
            for (int i2 = 1; i2 < 127; i2 += 2) {
                ATT1_ITER(pf, pfB, i2, true);
                ATT1_ITER(pfB, pf, i2 + 1, true);
            }
            ATT1_ITER(pf, pfB, 127, true);
#undef ATT1_ITER
#pragma unroll
            for (int q = 0; q < 4; ++q) pf[q] = pfB[q];
        } else {
        for (int i = 0; i < 128; ++i) {
            att_qk<MODE>(S0, S1, lds + kr, ka, qf);
            const float rm = att_rowmax(S0, S1);
            if (i == 0) mhat = rm;
            else if (__any(rm - mhat > THR)) { const float dl = fmaxf(rm - mhat, 0.f), f = __builtin_amdgcn_exp2f(-dl); lrun *= f; mhat += dl; fpend = f; havepend = true; }
            if (i > 0) att_pv(o, vring + vr, va, pf);
            att_exp(S0, S1, mhat, lrun, pf);
            ATT_RESC_O();
            ATT_DMA_K(kw); ATT_DMA_V(vw);
            if (i + 2 < 127) ATT_ADV_K();
            if (i + 1 < 127) ATT_ADV_V();
            kr = (kr == 2 * KB) ? 0 : kr + KB; kw = (kw == 2 * KB) ? 0 : kw + KB;
            vr = (vr == 2 * VB) ? 0 : vr + VB; vw = (vw == 2 * VB) ? 0 : vw + VB;
            asm volatile("s_waitcnt vmcnt(5) lgkmcnt(0)\n\ts_barrier" ::: "memory");
        }
        }
        att_pv(o, vring + vr, va, pf);
        asm volatile("s_waitcnt vmcnt(0) lgkmcnt(0)\n\ts_barrier" ::: "memory");
#undef ATT_DMA_K
#undef ATT_DMA_V
#undef ATT_ADV_K
#undef ATT_ADV_V
#undef ATT_RESC_O
        lrun = xor32_add(lrun);
        const float inv = 1.0f / lrun;
        bf16* orow = CAT + qrow * DM + h * 128;
        if (MODE == 0) {
#pragma unroll
            for (int db = 0; db < 4; ++db)
#pragma unroll
                for (int g4 = 0; g4 < 4; ++g4) {
                    const u32x2 w = {pk2(o[db][4 * g4] * inv, o[db][4 * g4 + 1] * inv), pk2(o[db][4 * g4 + 2] * inv, o[db][4 * g4 + 3] * inv)};
                    *(u32x2*)(orow + 32 * db + 8 * g4 + 4 * hh) = w;
                }
        } else {
            LAS float* ex = (LAS float*)lds + wq * 4096 + lane;
            if (map == 1) {
                const float f = lam * inv;
#pragma unroll
                for (int db = 0; db < 4; ++db)
#pragma unroll
                    for (int i = 0; i < 16; ++i) ex[(db * 16 + i) * 64] = o[db][i] * f;
            }
            __syncthreads();
            if (map == 0) {
                float ss = 0.f;
#pragma unroll
                for (int db = 0; db < 4; ++db)
#pragma unroll
                    for (int i = 0; i < 16; ++i) { const float v = o[db][i] * inv - ex[(db * 16 + i) * 64]; o[db][i] = v; ss += v * v; }
                ss = xor32_add(ss);
                const float rstd = rsqrtf(ss * (1.f / 128.f) + EPS);
#pragma unroll
                for (int db = 0; db < 4; ++db)
#pragma unroll
                    for (int g4 = 0; g4 < 4; ++g4) {
                        const u32x2 w = {pk2(o[db][4 * g4] * rstd, o[db][4 * g4 + 1] * rstd), pk2(o[db][4 * g4 + 2] * rstd, o[db][4 * g4 + 3] * rstd)};
                        *(u32x2*)(orow + 32 * db + 8 * g4 + 4 * hh) = w;
                    }
            }
            __syncthreads();
        }
    }
}

constexpr size_t WS_CTL = 5 * MiB, CTL_BYTES = 16384;
#define XB_TMO      128
#define XB_XCNT(j)  (256  + 64 * (j))
#define XB_XSUB(j)  (1280 + 64 * (j))
#define XB_XGEN(j)  (2304 + 64 * (j))
#define XB_TOP      3328
#define XB_TOPGEN   3392
#define XCD_BAR_WORDS 3456
#define XB_SPIN_CAP (1u << 18)

__device__ __forceinline__ unsigned xb_ld(unsigned* p)              { return __hip_atomic_load(p, __ATOMIC_RELAXED, __HIP_MEMORY_SCOPE_AGENT); }
__device__ __forceinline__ unsigned xb_add(unsigned* p, unsigned v) { return __hip_atomic_fetch_add(p, v, __ATOMIC_RELAXED, __HIP_MEMORY_SCOPE_AGENT); }
__device__ __forceinline__ unsigned xb_xcc_id() { return (unsigned)__builtin_amdgcn_s_getreg((3 << 11) | 20) & 0xFu; }
#define XB_SPIN(cond, bar) do { unsigned _sp = 0; while (cond) { \
    if ((++_sp & 255u) == 0u) { if (xb_ld(&(bar)[XB_TMO])) break; if (_sp > XB_SPIN_CAP) { atomicAdd(&(bar)[XB_TMO], 1u); break; } } } } while (0)

struct XcdBarrier {
    unsigned* bar; unsigned x;
    volatile LAS unsigned* st;
};

__device__ __forceinline__ XcdBarrier xcd_barrier_post(unsigned* bar, volatile LAS unsigned* st) {
    XcdBarrier b; b.bar = bar; b.x = xb_xcc_id(); b.st = st;
    if (threadIdx.x == 0) (void)xb_add(&bar[XB_XCNT(b.x)], 1u);
    return b;
}
__device__ __forceinline__ void xcd_barrier_complete(unsigned* bar, unsigned x, unsigned& nloc, unsigned& nx) {
    const unsigned G = gridDim.x * gridDim.y * gridDim.z;
    unsigned sum, cnt, mine, sp = 0u;
    for (;;) {
        sum = 0u; cnt = 0u; mine = 0u;
#pragma unroll
        for (unsigned j = 0; j < 16; ++j) { const unsigned c = xb_ld(&bar[XB_XCNT(j)]); sum += c; cnt += (c > 0u) ? 1u : 0u; mine = (j == x) ? c : mine; }
        if (sum == G) break;
        __builtin_amdgcn_s_sleep(1);
        if ((++sp & 255u) == 0u) { if (xb_ld(&bar[XB_TMO])) break; if (sp > XB_SPIN_CAP) { atomicAdd(&bar[XB_TMO], 1u); break; } }
    }
    nloc = mine > 0u ? mine : 1u; nx = cnt > 0u ? cnt : 1u;
}

__device__ __forceinline__ void xcd_barrier(const XcdBarrier& b) {
    asm volatile("s_waitcnt vmcnt(0)" ::: "memory");
    __syncthreads();
    if (threadIdx.x == 0) {
        unsigned* bar = b.bar;
        __builtin_amdgcn_s_waitcnt(0);
        unsigned nloc = b.st[0], nx = b.st[1];
        if (nloc == 0u) { xcd_barrier_complete(bar, b.x, nloc, nx); b.st[0] = nloc; b.st[1] = nx; }
        const unsigned old = xb_add(&bar[XB_XSUB(b.x)], 1u);
        const unsigned gen = old / nloc;
        if (old + 1u == (gen + 1u) * nloc) {
            __builtin_amdgcn_fence(__ATOMIC_RELEASE, "agent");
            asm volatile("s_waitcnt vmcnt(0)" ::: "memory");
            const unsigned og = xb_add(&bar[XB_TOP], 1u);
            const unsigned tg = og / nx;
            if (og + 1u == (tg + 1u) * nx) xb_add(&bar[XB_TOPGEN], 1u);
            else XB_SPIN(xb_ld(&bar[XB_TOPGEN]) == tg, bar);
            __builtin_amdgcn_fence(__ATOMIC_ACQUIRE, "agent");
            xb_add(&bar[XB_XGEN(b.x)], 1u);
            asm volatile("s_waitcnt vmcnt(0)" ::: "memory");
        } else {
            XB_SPIN(xb_ld(&bar[XB_XGEN(b.x)]) == gen, bar);
            __builtin_amdgcn_fence(__ATOMIC_ACQUIRE, "agent");
            asm volatile("s_waitcnt vmcnt(0)" ::: "memory");
        }
    }
    __syncthreads();
}

#ifndef MK_SINGLE
#define MK_SINGLE 1
#endif
constexpr int NPHASES = 47;
constexpr int LDS_BYTES = 147456;
struct Args { const float* in[34]; float* out; unsigned char* ws; double inv_m[32]; double inv_d[8]; int lo, hi; };

__global__ void __launch_bounds__(512, 2) mk_fwd(Args args) {
    extern __shared__ __attribute__((aligned(16))) unsigned char lds_raw[];
    LAS unsigned char* lds = (LAS unsigned char*)lds_raw;
    cg::grid_group grid = cg::this_grid();
    volatile LAS unsigned* xst = (volatile LAS unsigned*)(lds + 147456 - 64);
    if (threadIdx.x < 2) xst[threadIdx.x] = 0u;
    __syncthreads();
    if (args.hi - args.lo > 1) (void)xcd_barrier_post((unsigned*)(args.ws + WS_CTL), xst);
    const int lo = args.lo, hi = args.hi;
    int ph = 0;
#define PH_BEGIN if (ph >= lo && ph < hi) { \
    int tid_ = threadIdx.x; asm volatile("" : "+v"(tid_)); int zz_ = 0; asm volatile("" : "+s"(zz_)); \
    const int tid = tid_, lane = tid & 63, wave = __builtin_amdgcn_readfirstlane(tid >> 6); \
    const int G = gridDim.x, bx = blockIdx.x + zz_; \
    const int vcu = (G % 8 == 0) ? (bx % 8) * (G / 8) + bx / 8 : bx; \
    const int gw = bx * 8 + wave, NGW = G * 8; \
    unsigned char* ws = args.ws + zz_; \
    float* cosm = (float*)(ws + WS_COSM); float* sinm = (float*)(ws + WS_SINM); float* cosd = (float*)(ws + WS_COSD); float* sind = (float*)(ws + WS_SIND); \
    float2* s5A = (float2*)(ws + WS_S5A); float2* s5A64 = (float2*)(ws + WS_S5A64); bf16* s5BB = (bf16*)(ws + WS_S5BB); bf16* s5CT = (bf16*)(ws + WS_S5CT); \
    float* lamtab = (float*)(ws + WS_LAM); \
    bf16* Wb = (bf16*)(ws + WS_W); \
    bf16* XN = (bf16*)(ws + WS_XN); bf16* CAT = XN; \
    unsigned char* R1 = ws + WS_R1; \
    bf16* Hb = (bf16*)(R1 + R_H); \
    float* ZA = (float*)(R1 + R_ZA); float* Ub = (float*)(R1 + R_U); \
    bf16* Qb = (bf16*)(R1 + R_Q); bf16* KNb = (bf16*)(R1 + R_KN); bf16* VTb = (bf16*)(R1 + R_VT); \
    bf16* ZQN = (bf16*)(R1 + R_ZQN); bf16* ZKVN = (bf16*)(R1 + R_ZKVN); bf16* KPE = (bf16*)(R1 + R_KPE); bf16* YGb = (bf16*)(R1 + R_YGB); \
    float2* SLOC = (float2*)(R1 + R_SLOC); float2* CARRY = (float2*)(R1 + R_CARRY); \
    bf16* QD = (bf16*)(R1 + R_QD); bf16* KD = (bf16*)(R1 + R_KD); bf16* VTD = (bf16*)(R1 + R_VTD); \
    float* X = args.out + zz_; \
    const int j = (layer_ >> 1) + zz_; (void)j; \
    bf16* wl = Wb + (size_t)(layer_ + zz_) * W_FFN_L; bf16* we = Wb + W_EVEN0 + (size_t)j * W_EVEN_L; bf16* wo = Wb + W_ODD0 + (size_t)j * W_ODD_L; const int tb = j * 64; \
    (void)tid; (void)lane; (void)wave; (void)vcu; (void)gw; (void)NGW; (void)cosm; (void)sinm; (void)cosd; (void)sind; (void)s5A; (void)s5A64; (void)s5BB; (void)s5CT; (void)lamtab; (void)Wb; (void)XN; (void)CAT; \
    (void)Hb; (void)ZA; (void)Ub; (void)Qb; (void)KNb; (void)VTb; (void)ZQN; (void)ZKVN; (void)KPE; (void)YGb; (void)SLOC; (void)CARRY; (void)QD; (void)KD; (void)VTD; (void)X; (void)wl; (void)we; (void)wo; (void)tb;
#define PH_END   if (ph + 1 < hi) { if (hi < 0) grid.sync();   else { XcdBarrier xb_; xb_.bar = (unsigned*)ws + WS_CTL / 4; xb_.x = xb_xcc_id(); xb_.st = (volatile LAS unsigned*)(lds + 147456 - 64); xcd_barrier(xb_); } } } ++ph;
    int layer_ = 0;

    PH_BEGIN
#pragma unroll 1
        for (int i = 0; i < 4; ++i) {
            bf16* wlp = Wb + (size_t)i * W_FFN_L;
            const size_t o1 = (size_t)i * DM * FF;
            prep_w(args.in[2] + o1, DM, FF, wlp + W_GU1, 4, 1, 0, args.in[1] + i * DM, 0x7fffffff, 1.f, gw, NGW, lane, (LAS float*)(lds + wave * 8704));
            prep_w(args.in[3] + o1, DM, FF, wlp + W_GU1, 4, 1, 128, args.in[1] + i * DM, 0x7fffffff, 1.f, gw, NGW, lane, (LAS float*)(lds + wave * 8704));
            prep_w(args.in[4] + o1, FF, DM, wlp + W_D1, 0, 1, 0, nullptr, 0, 0.5f, gw, NGW, lane, (LAS float*)(lds + wave * 8704));
            prep_w(args.in[7] + o1, DM, FF, wlp + W_GU2, 4, 1, 0, args.in[6] + i * DM, 0x7fffffff, 1.f, gw, NGW, lane, (LAS float*)(lds + wave * 8704));
            prep_w(args.in[8] + o1, DM, FF, wlp + W_GU2, 4, 1, 128, args.in[6] + i * DM, 0x7fffffff, 1.f, gw, NGW, lane, (LAS float*)(lds + wave * 8704));
            prep_w(args.in[9] + o1, FF, DM, wlp + W_D2, 0, 1, 0, nullptr, 0, 0.5f, gw, NGW, lane, (LAS float*)(lds + wave * 8704));
        }
#pragma unroll 1
        for (int jj = 0; jj < 2; ++jj) { const int j = jj;
            bf16* we = Wb + W_EVEN0 + (size_t)j * W_EVEN_L;
            prep_w(args.in[10] + (size_t)j * DM * 1344, DM, 1344, we + W_WIN, 0, 1, 0, args.in[5] + (2 * j) * DM, 0x7fffffff, 1.f, gw, NGW, lane, (LAS float*)(lds + wave * 8704));
            for (int idx = gw * 64 + lane; idx < 192 * DM / 8; idx += NGW * 64) ((u32x4*)(we + W_WIN + (size_t)1344 * DM))[idx] = (u32x4){0u, 0u, 0u, 0u};
            prep_w(args.in[12] + (size_t)j * 512 * 768, 512, 768, we + W_QUP, 2, 1, 0, args.in[11] + j * 512, 0x7fffffff, 1.f, gw, NGW, lane, (LAS float*)(lds + wave * 8704));
            prep_w(args.in[14] + (size_t)j * 256 * 1024, 256, 1024, we + W_KVUP, 0, 1, 0, args.in[13] + j * 256, 0x7fffffff, 1.f, gw, NGW, lane, (LAS float*)(lds + wave * 8704));
            prep_w(args.in[23] + (size_t)j * 512 * 512, 512, 512, we + W_GLU, 0, 1, 0, nullptr, 0, 1.f, gw, NGW, lane, (LAS float*)(lds + wave * 8704));
            prep_w(args.in[25] + (size_t)j * DM * DM, DM, DM, we + W_WOUT, 0, 1, 0, nullptr, 0, 1.f, gw, NGW, lane, (LAS float*)(lds + wave * 8704));
            bf16* wo = Wb + W_ODD0 + (size_t)j * W_ODD_L;
            const float lam_init = 0.8f - 0.6f * expf(-0.3f * (float)(2 * j + 1));
            prep_w(args.in[26] + (size_t)j * DM * 3072, DM, 3072, wo + W_DIN, 3, 1, 0, args.in[5] + (2 * j + 1) * DM, 0x7fffffff, 1.f, gw, NGW, lane, (LAS float*)(lds + wave * 8704));
            prep_w(args.in[32] + (size_t)j * DM * DM, DM, DM, wo + W_DOUT, 0, 1, 0, args.in[31] + j * 128, 127, 1.f - lam_init, gw, NGW, lane, (LAS float*)(lds + wave * 8704));
        }
        for (int idx = bx * 512 + tid; idx < SEQ * 32; idx += G * 512) {
            const int pos = idx >> 5, t = idx & 31;
            const double rev = (double)pos * args.inv_m[t] * 0.15915494309189535; const float fr = (float)(rev - rint(rev));
            cosm[idx] = __builtin_amdgcn_cosf(fr); sinm[idx] = __builtin_amdgcn_sinf(fr);
        }
        for (int idx = bx * 512 + tid; idx < SEQ * 8; idx += G * 512) {
            const int pos = idx >> 3, t = idx & 7;
            const double rev = (double)pos * args.inv_d[t] * 0.15915494309189535; const float fr = (float)(rev - rint(rev));
            cosd[idx] = __builtin_amdgcn_cosf(fr); sind[idx] = __builtin_amdgcn_sinf(fr);
        }
        for (int idx = bx * 512 + tid; idx < 8192; idx += G * 512) {
            const int p = idx & 63, g = (idx >> 6) & 31, jd = idx >> 11;
            const float lr = args.in[15][idx], li = args.in[16][idx];
            const float dt = __expf(args.in[17][jd * 32 + g]);
            const float mag = __expf(lr * dt);
            const double rev = (double)(li * dt) * 0.15915494309189535; const float fr = (float)(rev - rint(rev));
            const float ar = mag * __builtin_amdgcn_cosf(fr), ai = mag * __builtin_amdgcn_sinf(fr);
            const float den = lr * lr + li * li, nr = ar - 1.0f;
            const float cre = (nr * lr + ai * li) / den, cim = (ai * lr - nr * li) / den;
            s5A[idx] = make_float2(ar, ai);
            float pr = ar, pi = ai;
#pragma unroll
            for (int q = 0; q < 6; ++q) { const float tr = pr * pr - pi * pi, ti = 2.f * pr * pi; pr = tr; pi = ti; }
            s5A64[idx] = make_float2(pr, pi);
            const float* br = args.in[18] + (size_t)idx * 16; const float* bi = args.in[19] + (size_t)idx * 16;
            const int colp = p & 31, half = p >> 5;
            bf16* bre = s5BB + ((size_t)(jd * 32 + g) * 128 + (2 * half) * 32 + colp) * 16;
            bf16* bim = s5BB + ((size_t)(jd * 32 + g) * 128 + (2 * half + 1) * 32 + colp) * 16;
#pragma unroll
            for (int c = 0; c < 16; c += 2) {
                const float r0 = cre * br[c] - cim * bi[c], r1 = cre * br[c + 1] - cim * bi[c + 1];
                const float i0 = cre * bi[c] + cim * br[c], i1 = cre * bi[c + 1] + cim * br[c + 1];
                *(unsigned*)(bre + c) = pk2(r0, r1); *(unsigned*)(bim + c) = pk2(i0, i1);
            }
            const float* cr = args.in[20] + (size_t)(jd * 32 + g) * 1024; const float* ci = args.in[21] + (size_t)(jd * 32 + g) * 1024;
            bf16* ct = s5CT + (size_t)(jd * 32 + g) * 2048;
#pragma unroll 4
            for (int c = 0; c < 16; ++c) *(unsigned*)(ct + c * 128 + 4 * colp + 2 * half) = pk2(cr[c * 64 + p], -ci[c * 64 + p]);
        }
        if (bx == 0 && tid < 2) {
            const int j = tid; float d1 = 0.f, d2 = 0.f;
            for (int e = 0; e < 64; ++e) { d1 += args.in[27][j * 64 + e] * args.in[28][j * 64 + e]; d2 += args.in[29][j * 64 + e] * args.in[30][j * 64 + e]; }
            lamtab[j] = expf(d1) - expf(d2) + (0.8f - 0.6f * expf(-0.3f * (float)(2 * j + 1)));
        }
        norm_rows(args.in[0], XN, gw, NGW, lane);
    PH_END

#pragma unroll 1
    for (int layer = 0; layer < 4; ++layer) {
        layer_ = layer;
#pragma unroll 1
        for (int half = 0; half < 2; ++half) {
            if (half == 1) {
                PH_BEGIN norm_rows(X, XN, gw, NGW, lane); PH_END
                if ((layer & 1) == 0) {
                    PH_BEGIN {
                        pg8::Gemm g{XN, we + W_WIN, M, ZN, DM}; pg8::StaticOrder S; S.init(M, ZN, G, bx);
                        EpiZ E{ZA, Ub};
                        pg8::gemm_phase<EpiZ, pg8::StaticOrder, true, true>(lds, g, S, E);
                    } PH_END
                    PH_BEGIN
                        post_rows(ZA, ZQN, ZKVN, KPE, cosm, sinm, gw, NGW, lane);
                        s5_pass<false>(lds + wave * 8704, Ub, s5A + (size_t)tb * 64, s5BB + (size_t)tb * 2048, s5CT + (size_t)tb * 2048, SLOC, CARRY, nullptr, nullptr, gw, NGW, lane);
                    PH_END
                    PH_BEGIN
                        s5_passB(s5A64 + (size_t)tb * 64, SLOC, CARRY);
                        {
                            pg8::Gemm g{ZQN, we + W_QUP, M, 768, 512}; pg8::StaticOrder S; S.init(M, 768, G, bx);
                            EpiQ E{Qb, cosm, sinm, 0.07216878364870322f * LOG2E};
                            pg8::gemm_phase<EpiQ, pg8::StaticOrder, true, true>(lds, g, S, E);
                        }
                        {
                            pg8::Gemm g{ZKVN, we + W_KVUP, M, 1024, 256}; pg8::StaticOrder S; S.init(M, 1024, G, bx);
                            EpiKV E{KNb, VTb};
                            pg8::gemm_phase<EpiKV, pg8::StaticOrder, true, true>(lds, g, S, E);
                        }
                    PH_END
                    PH_BEGIN
                        attn_phase<0>(lds, Qb, KNb, KPE, VTb, CAT, 0.f, vcu, G);
                        s5_pass<true>(lds + wave * 8704, Ub, s5A + (size_t)tb * 64, s5BB + (size_t)tb * 2048, s5CT + (size_t)tb * 2048, SLOC, CARRY, args.in[22] + j * 512, YGb, gw, NGW, lane);
                    PH_END
                    PH_BEGIN {
                        pg8::Gemm g{YGb, we + W_GLU, M, 512, 512}; pg8::StaticOrder S; S.init(M, 512, G, bx);
                        EpiGlu E{YGb, args.in[24] + j * 512, CAT};
                        pg8::gemm_phase<EpiGlu, pg8::StaticOrder, true, true>(lds, g, S, E);
                    } PH_END
                    PH_BEGIN {
                        pg8::Gemm g{CAT, we + W_WOUT, M, DM, DM}; pg8::StaticOrder S; S.init(M, DM, G, bx);
                        EpiResid E{X, X};
                        pg8::gemm_phase<EpiResid, pg8::StaticOrder, true, true>(lds, g, S, E);
                    } PH_END
                } else {
                    PH_BEGIN {
                        pg8::Gemm g{XN, wo + W_DIN, M, 3072, DM}; pg8::StaticOrder S; S.init(M, 3072, G, bx);
                        EpiDiffIn E{QD, KD, VTD, cosd, sind, 0.125f * LOG2E};
                        pg8::gemm_phase<EpiDiffIn, pg8::StaticOrder, true, true>(lds, g, S, E);
                    } PH_END
                    PH_BEGIN
                        attn_phase<1>(lds, QD, KD, nullptr, VTD, CAT, lamtab[j], vcu, G);
                    PH_END
                    PH_BEGIN {
                        pg8::Gemm g{CAT, wo + W_DOUT, M, DM, DM}; pg8::StaticOrder S; S.init(M, DM, G, bx);
                        EpiResid E{X, X};
                        pg8::gemm_phase<EpiResid, pg8::StaticOrder, true, true>(lds, g, S, E);
                    } PH_END
                }
                PH_BEGIN norm_rows(X, XN, gw, NGW, lane); PH_END
            }
            PH_BEGIN {
                pg8::Gemm g{XN, wl + (half ? W_GU2 : W_GU1), M, NGU, DM}; pg8::StaticOrder S; S.init(M, NGU, G, bx);
                EpiSwiglu E{Hb};
                pg8::gemm_phase<EpiSwiglu, pg8::StaticOrder, true, true>(lds, g, S, E);
            } PH_END
            PH_BEGIN {
                pg8::Gemm g{Hb, wl + (half ? W_D2 : W_D1), M, DM, FF}; pg8::StaticOrder S; S.init(M, DM, G, bx);
                EpiResid E{(layer == 0 && half == 0) ? args.in[0] : (const float*)X, X};
                pg8::gemm_phase<EpiResid, pg8::StaticOrder, true, true>(lds, g, S, E);
            } PH_END
        }
        if (layer < 3) { PH_BEGIN norm_rows(X, XN, gw, NGW, lane); PH_END }
    }
    PH_BEGIN final_norm_rows(X, args.in[33], gw, NGW, lane); PH_END
#undef PH_BEGIN
#undef PH_END
}

extern "C" void kernel_launch(void* const* d_in, const int* in_sizes, int n_in, void* d_out, int out_size, void* d_ws, size_t ws_size, hipStream_t stream) {
    static int grid = 0;
    if (grid == 0) {
        if (n_in != 34 || out_size != M * DM || ws_size < WS_NEED) { fprintf(stderr, "kernel_launch: unexpected shapes (n_in %d out %d ws %zu)\n", n_in, out_size, ws_size); grid = -1; return; }
        int dev = 0, cus = 0, per_cu = 0;
        (void)hipGetDevice(&dev); (void)hipDeviceGetAttribute(&cus, hipDeviceAttributeMultiprocessorCount, dev);
        if (hipFuncSetAttribute((const void*)mk_fwd, hipFuncAttributeMaxDynamicSharedMemorySize, LDS_BYTES) != hipSuccess) { fprintf(stderr, "kernel_launch: hipFuncSetAttribute failed\n"); grid = -1; return; }
        if (hipOccupancyMaxActiveBlocksPerMultiprocessor(&per_cu, (const void*)mk_fwd, 512, LDS_BYTES) != hipSuccess || per_cu < 1) { fprintf(stderr, "kernel_launch: occupancy query says %d\n", per_cu); per_cu = 1; }
        (void)hipGetLastError();
        grid = cus * 1;
        if (grid <= 0) grid = 256;
    }
    if (grid < 0) return;
    (void)hipMemsetAsync((unsigned char*)d_ws + WS_CTL, 0, CTL_BYTES, stream);
    Args a; memset(&a, 0, sizeof(a));
    for (int i = 0; i < 34; ++i) a.in[i] = (const float*)d_in[i];
    a.out = (float*)d_out; a.ws = (unsigned char*)d_ws;
    for (int t = 0; t < 32; ++t) a.inv_m[t] = pow(500000.0, -(double)(2 * t) / 64.0);
    for (int t = 0; t < 8; ++t) a.inv_d[t] = pow(500000.0, -(double)(2 * t) / 16.0);
#if MK_SINGLE
    a.lo = 0; a.hi = NPHASES;
    void* kargs[] = {&a};
    hipError_t e = hipLaunchCooperativeKernel((const void*)mk_fwd, dim3(grid), dim3(512), kargs, LDS_BYTES, stream);
    if (e != hipSuccess) fprintf(stderr, "kernel_launch: cooperative launch failed: %s (grid %d)\n", hipGetErrorString(e), grid);
#else
    for (int p = 0; p < NPHASES; ++p) {
        a.lo = p; a.hi = p + 1;
        hipLaunchKernelGGL(mk_fwd, dim3(grid), dim3(512), LDS_BYTES, stream, a);
    }
#endif
}
```

```cpp
#include <hip/hip_runtime.h>
#include <hip/hip_cooperative_groups.h>
#include <cstdio>
#include <cstdint>
#include <cstring>
#include <cmath>
namespace cg = cooperative_groups;
namespace pg8 {
#define PG8_LAS __attribute__((address_space(3)))
typedef unsigned short bf16_t;
typedef short bf16x8 __attribute__((ext_vector_type(8)));
typedef float f32x4 __attribute__((ext_vector_type(4)));
typedef unsigned u32x4 __attribute__((ext_vector_type(4)));
constexpr int BM = 256, BK = 64, HALF = 128, HTB = HALF * BK * 2  , STAGE_BYTES = 8 * HTB, NXCD = 8, WGM = 8;

__host__ __device__ __forceinline__ int lds_byte(int r, int c) { const int st = (r >> 4) * 2 + (c >> 5), rr = r & 15, cc = c & 31, ob = rr * 64 + cc * 2; return st * 1024 + (ob ^ (((ob >> 9) & 1) << 5)); }
__host__ __device__ __forceinline__ void stage_rc(int b, int& R, int& C) { const int st = b / 1024, sb = b % 1024, swz = sb ^ (((sb >> 9) & 1) << 5); R = (st >> 1) * 16 + swz / 64; C = (st & 1) * 32 + (swz % 64) / 2; }
__host__ __device__ __forceinline__ int perm32(int rho) { const int n = rho >> 4, i = rho & 15; return 8 * (i >> 2) + 4 * n + (i & 3); }

struct Unit { int pm, pn; };
struct Gemm { const bf16_t* A; const bf16_t* Bt; int M, N, K; };

struct StaticOrder {
    int nM, nN, nwg, G, c;
    __host__ __device__ void init(int M, int N, int G_, int c_) { nM = M / BM; nN = N / BM; nwg = nM * nN; G = G_; c = c_; }
    __host__ __device__ bool next(int i, Unit& u) const {
        const long L = (long)i * G + c; if (L >= nwg) return false;
        int wgid = (int)L; { const int q = nwg / NXCD, r = nwg % NXCD, xcd = wgid % NXCD, off = wgid / NXCD; wgid = (xcd < r ? xcd * (q + 1) : r * (q + 1) + (xcd - r) * q) + off; }
        const int nig = WGM * nN, gid = wgid / nig, fm = gid * WGM, gsz = (nM - fm) < WGM ? (nM - fm) : WGM;
        u.pm = fm + ((wgid % nig) % gsz); u.pn = (wgid % nig) / gsz; return true;
    }
    __device__ __forceinline__ void a_ready(const Unit&) const {}
    __device__ __forceinline__ void done(const Unit&) const {}
};

__device__ __forceinline__ unsigned cvt_pk_bf16(float lo, float hi) { unsigned r; asm volatile("v_cvt_pk_bf16_f32 %0, %1, %2" : "=v"(r) : "v"(lo), "v"(hi)); return r; }
typedef float f32x2 __attribute__((ext_vector_type(2)));
template <class Epi, class Sched, bool ALIGN_EPI = false, bool SP2 = false>
__device__ __forceinline__ void gemm_phase(PG8_LAS unsigned char* lds, const Gemm g, const Sched& S, const Epi& E) {
    int tid_ = threadIdx.x; asm volatile("" : "+v"(tid_)); const int tid = tid_, wid = __builtin_amdgcn_readfirstlane(tid >> 6), lane = tid & 63, wr = wid >> 2, wc = wid & 3, fr = lane & 15, fq = lane >> 4;
    const int K = g.K, nt = K / BK;
    unsigned voffA[2], voffB[2];
#pragma unroll
    for (int i = 0; i < 2; ++i) { int R, C; stage_rc(tid * 16 + i * 8192, R, C); const int Rb = Epi::PERM ? ((R & ~31) + perm32(R & 31)) : R;
        voffA[i] = (unsigned)(R * K + C) * 2u; voffB[i] = (unsigned)(Rb * K + C) * 2u; }
    const size_t kstep = (size_t)(BK * 2);
    const size_t hstep = (size_t)HALF * K * 2;
    const size_t tstep = 2 * hstep;
    const unsigned ldsw = (unsigned)wid * 1024u;
    const int aoff = lds_byte(wr * 64 + fr, fq * 8), boff = lds_byte(wc * 32 + fr, fq * 8);
#define PG8_SA(b, h) (((b) * 2 + (h)) * HTB)
#define PG8_SB(b, h) ((4 + (b) * 2 + (h)) * HTB)
#define PG8_STAGE(bufoff, gbase, voff) do { _Pragma("unroll") for (int _i = 0; _i < 2; ++_i) \
        __builtin_amdgcn_global_load_lds((const unsigned*)((const char*)(gbase) + (voff)[_i]), (PG8_LAS unsigned*)(lds + (bufoff) + ldsw + _i * 8192), 16, 0, 0); } while (0)
#define PG8_LDA(dst, b, h) do { _Pragma("unroll") for (int m = 0; m < 4; ++m) _Pragma("unroll") for (int k = 0; k < 2; ++k) dst[m][k] = *(const PG8_LAS bf16x8*)(lds + PG8_SA(b, h) + aoff + m * 2048 + k * 1024); } while (0)
#define PG8_LDB(dst, b, h) do { _Pragma("unroll") for (int n = 0; n < 2; ++n) _Pragma("unroll") for (int k = 0; k < 2; ++k) dst[n][k] = *(const PG8_LAS bf16x8*)(lds + PG8_SB(b, h) + boff + n * 2048 + k * 1024); } while (0)
#define PG8_MMA(ai, bj, At, Bt) do { __builtin_amdgcn_s_setprio(1); _Pragma("unroll") for (int m = 0; m < 4; ++m) _Pragma("unroll") for (int n = 0; n < 2; ++n) _Pragma("unroll") for (int k = 0; k < 2; ++k) \
        acc[ai][bj][m][n] = __builtin_amdgcn_mfma_f32_16x16x32_bf16(Bt[n][k], At[m][k], acc[ai][bj][m][n], 0, 0, 0); __builtin_amdgcn_s_setprio(0); } while (0)
#define PG8_WAIT_V(n) asm volatile("s_waitcnt vmcnt(" #n ")" ::: "memory")
#define PG8_WAIT_L(n) asm volatile("s_waitcnt lgkmcnt(" #n ")" ::: "memory")
#define PG8_BAR __builtin_amdgcn_s_barrier()
#define PG8_SCHED __builtin_amdgcn_sched_barrier(0)
    Unit cur, nxt; int ui = 0;
    if (!S.next(0, cur)) return;
    f32x4 acc[2][2][4][2];
#pragma unroll
    for (int a = 0; a < 2; ++a)
#pragma unroll
        for (int b = 0; b < 2; ++b)
#pragma unroll
            for (int m = 0; m < 4; ++m)
#pragma unroll
                for (int n = 0; n < 2; ++n) acc[a][b][m][n] = (f32x4){0.f, 0.f, 0.f, 0.f};
    bf16x8 At[4][2], B0[2][2], B1[2][2];
    const char* cA = (const char*)g.A + (size_t)cur.pm * tstep; const char* cB = (const char*)g.Bt + (size_t)cur.pn * tstep;
    S.a_ready(cur);
    if constexpr (SP2) {
        PG8_STAGE(PG8_SB(0, 0), cB, voffB); PG8_STAGE(PG8_SB(0, 1), cB + hstep, voffB); PG8_STAGE(PG8_SA(0, 0), cA, voffA); PG8_STAGE(PG8_SA(0, 1), cA + hstep, voffA);
        if (wr == 1) PG8_BAR;
        PG8_WAIT_V(2); PG8_BAR;
        PG8_STAGE(PG8_SB(1, 0), cB + kstep, voffB); PG8_STAGE(PG8_SA(1, 0), cA + kstep, voffA); PG8_STAGE(PG8_SB(1, 1), cB + hstep + kstep, voffB);
        PG8_WAIT_V(6); PG8_BAR;
    } else {
        PG8_STAGE(PG8_SB(0, 0), cB, voffB); PG8_STAGE(PG8_SA(0, 0), cA, voffA); PG8_STAGE(PG8_SB(0, 1), cB + hstep, voffB); PG8_STAGE(PG8_SA(0, 1), cA + hstep, voffA);
        if (wr == 1) PG8_BAR;
        PG8_WAIT_V(4); PG8_BAR;
        PG8_STAGE(PG8_SB(1, 0), cB + kstep, voffB); PG8_STAGE(PG8_SA(1, 0), cA + kstep, voffA); PG8_STAGE(PG8_SB(1, 1), cB + hstep + kstep, voffB);
        PG8_WAIT_V(6); PG8_BAR;
    }
    for (;;) {
        const bool has_next = S.next(ui + 1, nxt);
        const char* nA = has_next ? (const char*)g.A + (size_t)nxt.pm * tstep : cA; const char* nB = has_next ? (const char*)g.Bt + (size_t)nxt.pn * tstep : cB;
        for (int t = 0; t < nt; t += 2) {
            const bool last = (t == nt - 2);
            const char* a1 = cA + (size_t)(t + 1) * kstep;
            const char* a2 = last ? nA : cA + (size_t)(t + 2) * kstep; const char* b2 = last ? nB : cB + (size_t)(t + 2) * kstep;
            const char* a3 = a2 + kstep; const char* b3 = b2 + kstep;
            if (last && has_next) S.a_ready(nxt);
            if constexpr (SP2) {
            PG8_LDB(B0, 0, 0); PG8_LDB(B1, 0, 1); PG8_SCHED; PG8_LDA(At, 0, 0); PG8_STAGE(PG8_SA(1, 1), a1 + hstep, voffA);
            PG8_WAIT_V(8); PG8_WAIT_L(0); PG8_BAR; PG8_MMA(0, 0, At, B0); PG8_MMA(0, 1, At, B1); PG8_BAR; PG8_SCHED;
            PG8_LDA(At, 0, 1); PG8_STAGE(PG8_SB(0, 0), b2, voffB); PG8_STAGE(PG8_SB(0, 1), b2 + hstep, voffB); PG8_STAGE(PG8_SA(0, 0), a2, voffA);
            PG8_WAIT_V(8); PG8_WAIT_L(0); PG8_BAR; PG8_MMA(1, 0, At, B0); PG8_MMA(1, 1, At, B1); PG8_BAR; PG8_SCHED;
            PG8_LDB(B0, 1, 0); PG8_LDB(B1, 1, 1); PG8_SCHED; PG8_LDA(At, 1, 0); PG8_STAGE(PG8_SA(0, 1), a2 + hstep, voffA);
            PG8_WAIT_V(8); PG8_WAIT_L(0); PG8_BAR; PG8_MMA(0, 0, At, B0); PG8_MMA(0, 1, At, B1); PG8_BAR; PG8_SCHED;
            PG8_LDA(At, 1, 1); PG8_STAGE(PG8_SB(1, 0), b3, voffB); PG8_STAGE(PG8_SB(1, 1), b3 + hstep, voffB); PG8_STAGE(PG8_SA(1, 0), a3, voffA);
            PG8_WAIT_V(8); PG8_WAIT_L(0); PG8_BAR; PG8_MMA(1, 0, At, B0); PG8_MMA(1, 1, At, B1); PG8_BAR; PG8_SCHED;
            } else {
            PG8_LDB(B0, 0, 0); PG8_SCHED; PG8_LDA(At, 0, 0); PG8_STAGE(PG8_SA(1, 1), a1 + hstep, voffA);
            PG8_WAIT_L(8); PG8_BAR; PG8_WAIT_L(0); PG8_MMA(0, 0, At, B0); PG8_BAR; PG8_SCHED;
            PG8_LDB(B1, 0, 1); PG8_STAGE(PG8_SB(0, 0), b2, voffB);
            PG8_BAR; PG8_WAIT_L(0); PG8_MMA(0, 1, At, B1); PG8_BAR;
            PG8_LDA(At, 0, 1); PG8_STAGE(PG8_SA(0, 0), a2, voffA);
            PG8_BAR; PG8_WAIT_L(0); PG8_MMA(1, 0, At, B0); PG8_BAR; PG8_SCHED;
            PG8_STAGE(PG8_SB(0, 1), b2 + hstep, voffB);
            PG8_WAIT_V(6); PG8_BAR; PG8_MMA(1, 1, At, B1); PG8_BAR;
            PG8_LDB(B0, 1, 0); PG8_SCHED; PG8_LDA(At, 1, 0); PG8_STAGE(PG8_SA(0, 1), a2 + hstep, voffA);
            PG8_WAIT_L(8); PG8_BAR; PG8_WAIT_L(0); PG8_MMA(0, 0, At, B0); PG8_BAR; PG8_SCHED;
            PG8_LDB(B1, 1, 1); PG8_STAGE(PG8_SB(1, 0), b3, voffB);
            PG8_BAR; PG8_WAIT_L(0); PG8_MMA(0, 1, At, B1); PG8_BAR;
            PG8_LDA(At, 1, 1); PG8_STAGE(PG8_SA(1, 0), a3, voffA);
            PG8_BAR; PG8_WAIT_L(0); PG8_MMA(1, 0, At, B0); PG8_BAR; PG8_SCHED;
            PG8_STAGE(PG8_SB(1, 1), b3 + hstep, voffB);
            PG8_WAIT_V(6); PG8_BAR; PG8_MMA(1, 1, At, B1); PG8_BAR;
            }
        }
        if constexpr (ALIGN_EPI) { if (wr == 0) PG8_BAR; }
        if constexpr (!Epi::AFTER_DRAIN) { E(acc, cur, wr, wc, fr, fq); S.done(cur); }
        if (!has_next) break;
#pragma unroll
        for (int a = 0; a < 2; ++a)
#pragma unroll
            for (int b = 0; b < 2; ++b)
#pragma unroll
                for (int m = 0; m < 4; ++m)
#pragma unroll
                    for (int n = 0; n < 2; ++n) acc[a][b][m][n] = (f32x4){0.f, 0.f, 0.f, 0.f};
        cur = nxt; cA = nA; cB = nB; ++ui;
        if constexpr (ALIGN_EPI) { if (wr == 1) PG8_BAR; }
    }
    PG8_WAIT_V(0);
    if constexpr (!ALIGN_EPI) { if (wr == 0) PG8_BAR; }
    PG8_BAR;
    if constexpr (Epi::AFTER_DRAIN) { E.fused(acc, cur, wr, wc, fr, fq, lds, wid, lane); S.done(cur); }
#undef PG8_SA
#undef PG8_SB
#undef PG8_STAGE
#undef PG8_LDA
#undef PG8_LDB
#undef PG8_MMA
#undef PG8_WAIT_V
#undef PG8_WAIT_L
#undef PG8_BAR
#undef PG8_SCHED
}
}

#define LAS __attribute__((address_space(3)))
typedef unsigned short bf16;
typedef short bf16x8 __attribute__((ext_vector_type(8)));
typedef float f32x4 __attribute__((ext_vector_type(4)));
typedef float f32x16 __attribute__((ext_vector_type(16)));
typedef unsigned u32x4 __attribute__((ext_vector_type(4)));
typedef unsigned u32x2 __attribute__((ext_vector_type(2)));
typedef float f32x2_t __attribute__((ext_vector_type(2)));
typedef __bf16 bf16x2_t __attribute__((ext_vector_type(2)));
using pg8::Unit;

constexpr int M = 32768, SEQ = 8192, DM = 1024, FF = 2816, NGU = 5632;
constexpr float EPS = 1e-6f;
constexpr float LOG2E = 1.4426950408889634f;
constexpr size_t MiB = (size_t)1 << 20;
constexpr size_t WS_COSM = 0, WS_SINM = 1 * MiB, WS_COSD = 2 * MiB, WS_SIND = 2 * MiB + 256 * 1024;
constexpr size_t WS_S5A = 2 * MiB + 512 * 1024, WS_S5A64 = WS_S5A + 64 * 1024, WS_S5BB = 3 * MiB, WS_S5CT = 3 * MiB + 512 * 1024, WS_LAM = 4 * MiB;
constexpr size_t WS_W = 8 * MiB, WS_XN = 170 * MiB, WS_R1 = 234 * MiB, WS_NEED = 496 * MiB;
constexpr size_t W_FFN_L = 17301504, W_GU1 = 0, W_D1 = 5767168, W_GU2 = 8650752, W_D2 = 14417920;
constexpr size_t W_EVEN0 = 69206016, W_EVEN_L = 3538944, W_WIN = 0, W_QUP = 1572864, W_KVUP = 1966080, W_GLU = 2228224, W_WOUT = 2490368;
constexpr size_t W_ODD0 = W_EVEN0 + 2 * W_EVEN_L, W_ODD_L = 4194304, W_DIN = 0, W_DOUT = 3145728;
constexpr size_t R_H = 0;
constexpr size_t R_ZA = 0, R_Q = 0, R_KN = 48 * MiB, R_VT = 80 * MiB, R_U = 112 * MiB, R_ZQN = 176 * MiB, R_YGB = 176 * MiB, R_ZKVN = 208 * MiB, R_KPE = 224 * MiB,
                 R_SLOC = 228 * MiB, R_CARRY = 244 * MiB;
constexpr size_t R_QD = 0, R_KD = 64 * MiB, R_VTD = 128 * MiB;
constexpr int ZA_LD = 832, ZN = 1536;

__device__ __forceinline__ unsigned pk2(float lo, float hi) { f32x2_t v = {lo, hi}; bf16x2_t b = __builtin_convertvector(v, bf16x2_t); return __builtin_bit_cast(unsigned, b); }
__device__ __forceinline__ bf16x8 pack8(f32x4 a, f32x4 b) { u32x4 w = {pk2(a[0], a[1]), pk2(a[2], a[3]), pk2(b[0], b[1]), pk2(b[2], b[3])}; return __builtin_bit_cast(bf16x8, w); }
__device__ __forceinline__ float bf2f(unsigned short v) { return __uint_as_float((unsigned)v << 16); }
__device__ __forceinline__ float xor32_max(float v) { auto rr = __builtin_amdgcn_permlane32_swap(__float_as_uint(v), __float_as_uint(v), false, false); return fmaxf(__uint_as_float(rr[0]), __uint_as_float(rr[1])); }
__device__ __forceinline__ float xor32_add(float v) { auto rr = __builtin_amdgcn_permlane32_swap(__float_as_uint(v), __float_as_uint(v), false, false); return __uint_as_float(rr[0]) + __uint_as_float(rr[1]); }
#define SWZ_XOR(v, m) __int_as_float(__builtin_amdgcn_ds_swizzle(__float_as_int(v), 0x1f | ((m) << 10)))
__device__ __forceinline__ float wave_sum(float v) {
    v += SWZ_XOR(v, 1); v += SWZ_XOR(v, 2); v += SWZ_XOR(v, 4); v += SWZ_XOR(v, 8); v += SWZ_XOR(v, 16);
    return xor32_add(v);
}
__device__ __forceinline__ float sigmoidf_(float v) { return __builtin_amdgcn_rcpf(1.0f + __builtin_amdgcn_exp2f(v * -1.4426950408889634f)); }
#define MFMA32(a, b, c) __builtin_amdgcn_mfma_f32_32x32x16_bf16((a), (b), (c), 0, 0, 0)
#define MFMA16(a, b, c) __builtin_amdgcn_mfma_f32_16x16x32_bf16((a), (b), (c), 0, 0, 0)

#define EPI_LOOP_BEGIN \
    _Pragma("unroll") for (int ai = 0; ai < 2; ++ai) _Pragma("unroll") for (int m = 0; m < 4; ++m) _Pragma("unroll") for (int bj = 0; bj < 2; ++bj) { \
        const int row = u.pm * 256 + ai * 128 + wr * 64 + m * 16 + fr; const int col0 = u.pn * 256 + bj * 128 + wc * 32 + 8 * fq; \
        const f32x4 v0 = acc[ai][bj][m][0], v1 = acc[ai][bj][m][1]; (void)row; (void)col0;
#define EPI_LOOP_END }

struct EpiSwiglu {
    static constexpr bool PERM = true, AFTER_DRAIN = false;
    bf16* H;
    __device__ __forceinline__ void operator()(const f32x4 (&acc)[2][2][4][2], const Unit& u, int wr, int wc, int fr, int fq) const {
#pragma unroll
        for (int ai = 0; ai < 2; ++ai)
#pragma unroll
            for (int m = 0; m < 4; ++m) {
                const int row = u.pm * 256 + ai * 128 + wr * 64 + m * 16 + fr, f0 = u.pn * 128 + wc * 32 + 8 * fq;
                const f32x4 g0 = acc[ai][0][m][0], g1 = acc[ai][0][m][1], u0 = acc[ai][1][m][0], u1 = acc[ai][1][m][1];
                f32x4 o0, o1;
#pragma unroll
                for (int e = 0; e < 4; ++e) { o0[e] = g0[e] * sigmoidf_(g0[e]) * u0[e]; o1[e] = g1[e] * sigmoidf_(g1[e]) * u1[e]; }
                *(bf16x8*)(H + (size_t)row * FF + f0) = pack8(o0, o1);
            }
    }
};
struct EpiResid {
    static constexpr bool PERM = true, AFTER_DRAIN = false;
    const float* src; float* dst;
    __device__ __forceinline__ void operator()(const f32x4 (&acc)[2][2][4][2], const Unit& u, int wr, int wc, int fr, int fq) const {
        EPI_LOOP_BEGIN
            const size_t off = (size_t)row * DM + col0;
            const f32x4 a = *(const f32x4*)(src + off), b = *(const f32x4*)(src + off + 4);
            *(f32x4*)(dst + off) = a + v0; *(f32x4*)(dst + off + 4) = b + v1;
        EPI_LOOP_END
    }
};
struct EpiZ {
    static constexpr bool PERM = true, AFTER_DRAIN = false;
    float* ZA; float* U;
    __device__ __forceinline__ void operator()(const f32x4 (&acc)[2][2][4][2], const Unit& u, int wr, int wc, int fr, int fq) const {
        EPI_LOOP_BEGIN
            if (col0 < 832) { float* p = ZA + (size_t)row * ZA_LD + col0; *(f32x4*)p = v0; *(f32x4*)(p + 4) = v1; }
            else if (col0 < 1344) { float* p = U + (size_t)row * 512 + (col0 - 832); *(f32x4*)p = v0; *(f32x4*)(p + 4) = v1; }
        EPI_LOOP_END
    }
};
struct EpiQ {
    static constexpr bool PERM = true, AFTER_DRAIN = false;
    bf16* Q; const float* cosm; const float* sinm; float qs;
    __device__ __forceinline__ void operator()(const f32x4 (&acc)[2][2][4][2], const Unit& u, int wr, int wc, int fr, int fq) const {
        EPI_LOOP_BEGIN
            f32x4 a = v0, b = v1;
            const int hq = col0 / 192, d = col0 - hq * 192;
            if (d >= 128) {
                const int t0 = (d - 128) >> 1; const int pos = row & (SEQ - 1);
                const f32x4 c = *(const f32x4*)(cosm + pos * 32 + t0), s = *(const f32x4*)(sinm + pos * 32 + t0);
                a = (f32x4){v0[0] * c[0] - v0[1] * s[0], v0[1] * c[0] + v0[0] * s[0], v0[2] * c[1] - v0[3] * s[1], v0[3] * c[1] + v0[2] * s[1]};
                b = (f32x4){v1[0] * c[2] - v1[1] * s[2], v1[1] * c[2] + v1[0] * s[2], v1[2] * c[3] - v1[3] * s[3], v1[3] * c[3] + v1[2] * s[3]};
            }
            a = a * qs; b = b * qs;
            *(bf16x8*)(Q + (size_t)row * 768 + col0) = pack8(a, b);
        EPI_LOOP_END
    }
};
struct EpiKV {
    static constexpr bool PERM = true, AFTER_DRAIN = false;
    bf16* KN; bf16* VT;
    __device__ __forceinline__ void operator()(const f32x4 (&acc)[2][2][4][2], const Unit& u, int wr, int wc, int fr, int fq) const {
        EPI_LOOP_BEGIN
            const int hq = u.pn, dl = wc * 32 + 8 * fq;
            if (bj == 0) { *(bf16x8*)(KN + (size_t)row * 512 + hq * 128 + dl) = pack8(v0, v1); }
            else {
                const int b = row >> 13, s0_ = row & (SEQ - 1), s = (s0_ & ~15) | (((s0_ >> 2) & 1) << 3) | (((s0_ >> 3) & 1) << 2) | (s0_ & 3);
                bf16* p = VT + ((size_t)((b * 4 + hq) * 128 + dl)) * SEQ + s;
                const bf16x8 w = pack8(v0, v1);
#pragma unroll
                for (int e = 0; e < 8; ++e) p[(size_t)e * SEQ] = (bf16)w[e];
            }
        EPI_LOOP_END
    }
};
struct EpiDiffIn {
    static constexpr bool PERM = true, AFTER_DRAIN = false;
    bf16* QD; bf16* KD; bf16* VT; const float* cosd; const float* sind; float qs;
    __device__ __forceinline__ void operator()(const f32x4 (&acc)[2][2][4][2], const Unit& u, int wr, int wc, int fr, int fq) const {
        EPI_LOOP_BEGIN
            if (col0 < 2048) {
                f32x4 a = v0, b = v1;
                const int d = col0 & 63;
                if (d < 16) {
                    const int t0 = d >> 1; const int pos = row & (SEQ - 1);
                    const f32x4 c = *(const f32x4*)(cosd + pos * 8 + t0), s = *(const f32x4*)(sind + pos * 8 + t0);
                    a = (f32x4){v0[0] * c[0] - v0[1] * s[0], v0[1] * c[0] + v0[0] * s[0], v0[2] * c[1] - v0[3] * s[1], v0[3] * c[1] + v0[2] * s[1]};
                    b = (f32x4){v1[0] * c[2] - v1[1] * s[2], v1[1] * c[2] + v1[0] * s[2], v1[2] * c[3] - v1[3] * s[3], v1[3] * c[3] + v1[2] * s[3]};
                }
                if (col0 < 1024) { a = a * qs; b = b * qs; *(bf16x8*)(QD + (size_t)row * 1024 + col0) = pack8(a, b); }
                else { *(bf16x8*)(KD + (size_t)row * 1024 + (col0 - 1024)) = pack8(a, b); }
            } else {
                const int hv = (col0 - 2048) >> 7, dl = col0 & 127;
                const int b = row >> 13, s0_ = row & (SEQ - 1), s = (s0_ & ~15) | (((s0_ >> 2) & 1) << 3) | (((s0_ >> 3) & 1) << 2) | (s0_ & 3);
                bf16* p = VT + ((size_t)((b * 8 + hv) * 128 + dl)) * SEQ + s;
                const bf16x8 w = pack8(v0, v1);
#pragma unroll
                for (int e = 0; e < 8; ++e) p[(size_t)e * SEQ] = (bf16)w[e];
            }
        EPI_LOOP_END
    }
};
struct EpiGlu {
    static constexpr bool PERM = true, AFTER_DRAIN = false;
    const bf16* YG; const float* bias; bf16* CAT;
    __device__ __forceinline__ void operator()(const f32x4 (&acc)[2][2][4][2], const Unit& u, int wr, int wc, int fr, int fq) const {
        EPI_LOOP_BEGIN
            const f32x4 b0 = *(const f32x4*)(bias + col0), b1 = *(const f32x4*)(bias + col0 + 4);
            const bf16x8 y = *(const bf16x8*)(YG + (size_t)row * 512 + col0);
            f32x4 o0, o1;
#pragma unroll
            for (int e = 0; e < 4; ++e) { o0[e] = bf2f((unsigned short)y[e]) * sigmoidf_(v0[e] + b0[e]); o1[e] = bf2f((unsigned short)y[4 + e]) * sigmoidf_(v1[e] + b1[e]); }
            *(bf16x8*)(CAT + (size_t)row * DM + 512 + col0) = pack8(o0, o1);
        EPI_LOOP_END
    }
};

__device__ __forceinline__ void prep_w(const float* W, int K, int N, bf16* dst, int mode, int omul, int oadd, const float* gain, int gmask, float scale, int gw, int NGW, int lane, LAS float* scr) {
    const int nkb = K >> 6, nnb = N >> 5, nitems = nkb * nnb;
    const int hl = lane >> 5, l31 = lane & 31, c = lane & 7, r8 = lane >> 3;
    for (int it = gw; it < nitems; it += NGW) {
        const int kb = it / nnb, nb = it - kb * nnb, k0 = kb * 64, n0 = nb * 32;
        const float* src = W + (size_t)(k0 + hl) * N + n0 + l31;
        float v[32];
#pragma unroll
        for (int i = 0; i < 32; ++i) v[i] = src[(size_t)(2 * i) * N];
#pragma unroll
        for (int i = 0; i < 32; ++i) { const int k = k0 + 2 * i + hl; const float g = gain ? gain[k & gmask] * scale : scale; scr[(2 * i + hl) * 33 + l31] = v[i] * g; }
        asm volatile("s_waitcnt lgkmcnt(0)" ::: "memory");
#pragma unroll
        for (int j = 0; j < 4; ++j) {
            const int nl = r8 + 8 * j, n = n0 + nl;
            int nd = n;
            if (mode == 2) { const int hq = n / 192; int d = n - hq * 192; if (d >= 128) { const int dd = d - 128; d = 128 + 2 * (dd & 31) + (dd >> 5); } nd = hq * 192 + d; }
            else if (mode == 3) { if (n < 2048) { int d = n & 63; if (d < 16) d = 2 * (d & 7) + (d >> 3); nd = (n & ~63) + d; } }
            if (mode == 4) nd = (n >> 7) * 256 + (n & 127) + oadd; else nd = nd * omul + oadd;
            const LAS float* sp = scr + (8 * c) * 33 + nl;
            const f32x4 a = {sp[0], sp[33], sp[66], sp[99]}, b = {sp[132], sp[165], sp[198], sp[231]};
            *(bf16x8*)(dst + (size_t)nd * K + k0 + 8 * c) = pack8(a, b);
        }
        asm volatile("s_waitcnt lgkmcnt(0)" ::: "memory");
    }
}

__device__ __forceinline__ void norm_rows(const float* x, bf16* xn, int gw, int NGW, int lane) {
    for (int row = gw; row < M; row += 2 * NGW) {
        const int row2 = row + NGW; const bool has2 = row2 < M;
        const f32x4* xr = (const f32x4*)(x + (size_t)row * DM) + lane;
        const f32x4* xr2 = (const f32x4*)(x + (size_t)(has2 ? row2 : row) * DM) + lane;
        f32x4 v[4], w[4]; float s = 0.f, s2 = 0.f;
#pragma unroll
        for (int j = 0; j < 4; ++j) { v[j] = xr[64 * j]; w[j] = xr2[64 * j]; }
#pragma unroll
        for (int j = 0; j < 4; ++j) { s += (v[j][0] * v[j][0] + v[j][1] * v[j][1]) + (v[j][2] * v[j][2] + v[j][3] * v[j][3]); s2 += (w[j][0] * w[j][0] + w[j][1] * w[j][1]) + (w[j][2] * w[j][2] + w[j][3] * w[j][3]); }
        const float rstd = rsqrtf(wave_sum(s) * (1.f / DM) + EPS), rstd2 = rsqrtf(wave_sum(s2) * (1.f / DM) + EPS);
        u32x2* o = (u32x2*)(xn + (size_t)row * DM) + lane;
#pragma unroll
        for (int j = 0; j < 4; ++j) o[64 * j] = (u32x2){pk2(v[j][0] * rstd, v[j][1] * rstd), pk2(v[j][2] * rstd, v[j][3] * rstd)};
        if (has2) {
            u32x2* o2 = (u32x2*)(xn + (size_t)row2 * DM) + lane;
#pragma unroll
            for (int j = 0; j < 4; ++j) o2[64 * j] = (u32x2){pk2(w[j][0] * rstd2, w[j][1] * rstd2), pk2(w[j][2] * rstd2, w[j][3] * rstd2)};
        }
    }
}
__device__ __forceinline__ void final_norm_rows(float* x, const float* gain, int gw, int NGW, int lane) {
    for (int row = gw; row < M; row += 2 * NGW) {
        const int row2 = (row + NGW < M) ? row + NGW : row;
        f32x4* xr = (f32x4*)(x + (size_t)row * DM) + lane; f32x4* xr2 = (f32x4*)(x + (size_t)row2 * DM) + lane;
        f32x4 v[4], w[4]; float s = 0.f, s2 = 0.f;
#pragma unroll
        for (int j = 0; j < 4; ++j) { v[j] = xr[64 * j]; w[j] = xr2[64 * j]; }
#pragma unroll
        for (int j = 0; j < 4; ++j) { s += (v[j][0] * v[j][0] + v[j][1] * v[j][1]) + (v[j][2] * v[j][2] + v[j][3] * v[j][3]); s2 += (w[j][0] * w[j][0] + w[j][1] * w[j][1]) + (w[j][2] * w[j][2] + w[j][3] * w[j][3]); }
        const float rstd = rsqrtf(wave_sum(s) * (1.f / DM) + EPS), rstd2 = rsqrtf(wave_sum(s2) * (1.f / DM) + EPS);
#pragma unroll
        for (int j = 0; j < 4; ++j) { const f32x4 g = ((const f32x4*)gain)[lane + 64 * j]; xr[64 * j] = v[j] * rstd * g; if (row2 != row) xr2[64 * j] = w[j] * rstd2 * g; }
    }
}
__device__ __forceinline__ void post_rows(const float* ZA, bf16* ZQN, bf16* ZKVN, bf16* KPE, const float* cosm, const float* sinm, int gw, int NGW, int lane) {
    for (int row = gw; row < M; row += NGW) {
        const float* za = ZA + (size_t)row * ZA_LD;
        const f32x4 a0 = ((const f32x4*)za)[lane], a1 = ((const f32x4*)za)[64 + lane], kv = ((const f32x4*)(za + 512))[lane];
        float sq = (a0[0] * a0[0] + a0[1] * a0[1]) + (a0[2] * a0[2] + a0[3] * a0[3]) + (a1[0] * a1[0] + a1[1] * a1[1]) + (a1[2] * a1[2] + a1[3] * a1[3]);
        float sk = (kv[0] * kv[0] + kv[1] * kv[1]) + (kv[2] * kv[2] + kv[3] * kv[3]);
        const float rq = rsqrtf(wave_sum(sq) * (1.f / 512.f) + EPS), rk = rsqrtf(wave_sum(sk) * (1.f / 256.f) + EPS);
        u32x2* oq = (u32x2*)(ZQN + (size_t)row * 512);
        oq[lane] = (u32x2){pk2(a0[0] * rq, a0[1] * rq), pk2(a0[2] * rq, a0[3] * rq)};
        oq[64 + lane] = (u32x2){pk2(a1[0] * rq, a1[1] * rq), pk2(a1[2] * rq, a1[3] * rq)};
        ((u32x2*)(ZKVN + (size_t)row * 256))[lane] = (u32x2){pk2(kv[0] * rk, kv[1] * rk), pk2(kv[2] * rk, kv[3] * rk)};
        if (lane < 32) {
            const float x1 = za[768 + lane], x2 = za[800 + lane]; const int pos = row & (SEQ - 1);
            const float c = cosm[pos * 32 + lane], s = sinm[pos * 32 + lane];
            ((unsigned*)(KPE + (size_t)row * 64))[lane] = pk2(x1 * c - x2 * s, x2 * c + x1 * s);
        }
    }
}

template <bool PC>
__device__ __forceinline__ void s5_pass(LAS unsigned char* xl  , const float* U, const float2* Atab, const bf16* BB, const bf16* CT,
                                        float2* SLOC, const float2* CARRY, const float* dvec, bf16* YGb, int gw, int NGW, int lane) {
    const int col = lane & 31, hi = lane >> 5;
    const int aseq = (col >> 2) & 1, ai_ = (col & 3) + 4 * (col >> 3);
    const int c16 = lane & 15, quad = lane >> 4;
    for (int u = gw; u < 8192; u += NGW) {
        const int g = u & 31, bp = (u >> 5) & 1, ch = u >> 6;
        const int b0 = bp * 2, t0 = ch * 64;
        bf16x8 ua[4];
#pragma unroll
        for (int blk = 0; blk < 4; ++blk) {
            const float* p = U + ((size_t)((b0 + aseq) * SEQ + t0 + 16 * blk + ai_)) * 512 + g * 16 + 8 * hi;
            ua[blk] = pack8(*(const f32x4*)p, *(const f32x4*)(p + 4));
        }
        f32x4 acc[2][4];
#pragma unroll
        for (int s = 0; s < 2; ++s)
#pragma unroll
            for (int b = 0; b < 4; ++b) acc[s][b] = (f32x4){0.f, 0.f, 0.f, 0.f};
#pragma unroll
        for (int dir = 0; dir < 2; ++dir) {
            const int tb = dir * 32 + g;
            bf16x8 bbf[4];
#pragma unroll
            for (int q = 0; q < 4; ++q) bbf[q] = *(const bf16x8*)(BB + ((size_t)tb * 128 + q * 32 + col) * 16 + 8 * hi);
            const float2 a0 = Atab[tb * 64 + col], a1 = Atab[tb * 64 + col + 32];
            const size_t sidx = ((size_t)((dir * 4 + b0 + hi) * 32 + g) * 128 + ch) * 64;
            float xr0 = 0.f, xi0 = 0.f, xr1 = 0.f, xi1 = 0.f;
            bf16x8 ctf[4];
            if (PC) {
                const float2 c0 = CARRY[sidx + col], c1 = CARRY[sidx + col + 32];
                xr0 = c0.x; xi0 = c0.y; xr1 = c1.x; xi1 = c1.y;
#pragma unroll
                for (int kq = 0; kq < 4; ++kq) ctf[kq] = *(const bf16x8*)(CT + ((size_t)tb * 16 + c16) * 128 + 32 * kq + 8 * quad);
            }
#pragma unroll
            for (int bb = 0; bb < 4; ++bb) {
                const int blk = dir ? 3 - bb : bb;
                f32x16 bu[4];
                const f32x16 zero = {0.f, 0.f, 0.f, 0.f, 0.f, 0.f, 0.f, 0.f, 0.f, 0.f, 0.f, 0.f, 0.f, 0.f, 0.f, 0.f};
#pragma unroll
                for (int q = 0; q < 4; ++q) bu[q] = MFMA32(ua[blk], bbf[q], zero);
#pragma unroll
                for (int ii = 0; ii < 16; ++ii) {
                    const int i = dir ? 15 - ii : ii;
                    const float nr0 = a0.x * xr0 - a0.y * xi0 + bu[0][i], ni0 = a0.x * xi0 + a0.y * xr0 + bu[1][i];
                    const float nr1 = a1.x * xr1 - a1.y * xi1 + bu[2][i], ni1 = a1.x * xi1 + a1.y * xr1 + bu[3][i];
                    xr0 = nr0; xi0 = ni0; xr1 = nr1; xi1 = ni1;
                    if (PC) *(LAS u32x2*)(xl + (16 * hi + i) * 272 + col * 8) = (u32x2){pk2(xr0, xi0), pk2(xr1, xi1)};
                }
                if (PC) {
#pragma unroll
                    for (int s = 0; s < 2; ++s)
#pragma unroll
                        for (int kq = 0; kq < 4; ++kq) {
                            const bf16x8 xa = *(const LAS bf16x8*)(xl + (16 * s + c16) * 272 + (32 * kq + 8 * quad) * 2);
                            acc[s][blk] = MFMA16(xa, ctf[kq], acc[s][blk]);
                        }
                }
            }
            if (!PC) { SLOC[sidx + col] = make_float2(xr0, xi0); SLOC[sidx + col + 32] = make_float2(xr1, xi1); }
        }
        if (PC) {
            const int cc = g * 16 + c16; const float dv = dvec[cc];
#pragma unroll
            for (int s = 0; s < 2; ++s)
#pragma unroll
                for (int blk = 0; blk < 4; ++blk)
#pragma unroll
                    for (int j = 0; j < 4; ++j) {
                        const size_t row = (size_t)(b0 + s) * SEQ + t0 + 16 * blk + 4 * quad + j;
                        float y = acc[s][blk][j] + dv * U[row * 512 + cc];
                        const float z2 = 1.5957691216f * (y + 0.044715f * y * y * y);
                        y = y * __builtin_amdgcn_rcpf(1.0f + __builtin_amdgcn_exp2f(z2 * -1.4426950408889634f));
                        YGb[row * 512 + cc] = (bf16)(pk2(y, 0.f) & 0xffffu);
                    }
        }
    }
}
__device__ __forceinline__ void s5_passB(const float2* A64, const float2* SLOC, float2* CARRY) {
    int tid_ = threadIdx.x; asm volatile("" : "+v"(tid_));
    if (tid_ >= 64) return;
    for (int idx = blockIdx.x * 64 + tid_; idx < 16384; idx += gridDim.x * 64) {
        const int dir = idx >> 13, rest = idx & 8191, b = rest >> 11, g = (rest >> 6) & 31, p = rest & 63;
        const float2 a = A64[(dir * 32 + g) * 64 + p];
        const size_t base = ((size_t)((dir * 4 + b) * 32 + g) * 128) * 64 + p;
        float cr = 0.f, ci = 0.f;
#pragma unroll 1
        for (int kk0 = 0; kk0 < 128; kk0 += 32) {
            float2 sv[32];
#pragma unroll
            for (int j = 0; j < 32; ++j) { const int k = dir ? 127 - (kk0 + j) : kk0 + j; sv[j] = SLOC[base + (size_t)k * 64]; }
#pragma unroll
            for (int j = 0; j < 32; ++j) {
                const int k = dir ? 127 - (kk0 + j) : kk0 + j;
                CARRY[base + (size_t)k * 64] = make_float2(cr, ci);
                const float nr = a.x * cr - a.y * ci + sv[j].x, ni = a.x * ci + a.y * cr + sv[j].y;
                cr = nr; ci = ni;
            }
        }
    }
}

__device__ __forceinline__ void glds16(const void* gsrc, unsigned lds_dst) {
    unsigned keep;
    asm volatile("s_mov_b32 %0, m0\n\ts_mov_b32 m0, %2\n\ts_nop 0\n\tglobal_load_lds_dwordx4 %1, off\n\ts_mov_b32 m0, %0" : "=&s"(keep) : "v"(gsrc), "s"(lds_dst) : "memory");
}
template <int MODE>
__device__ __forceinline__ void att_qk(f32x16& s0, f32x16& s1, const LAS unsigned char* kslot, int ka, const bf16x8 (&qf)[MODE == 0 ? 12 : 4]) {
    constexpr int NKS = MODE == 0 ? 12 : 4, RB = MODE == 0 ? 384 : 256;
    f32x16 z;
#pragma unroll
    for (int i = 0; i < 16; ++i) z[i] = 0.f;
#pragma unroll
    for (int ks = 0; ks < NKS; ++ks) {
        const LAS unsigned char* p = kslot + ((ka ^ ((ks & 3) * 32)) + (ks >> 2) * 128);
        const bf16x8 a0 = *(const LAS bf16x8*)p, a1 = *(const LAS bf16x8*)(p + 32 * RB);
        if (ks == 0) { s0 = MFMA32(a0, qf[0], z); s1 = MFMA32(a1, qf[0], z); }
        else { s0 = MFMA32(a0, qf[ks], s0); s1 = MFMA32(a1, qf[ks], s1); }
    }
}
__device__ __forceinline__ float att_rowmax(const f32x16& s0, const f32x16& s1) {
    float a = fmaxf(fmaxf(s0[0], s0[1]), s1[0]), b = fmaxf(fmaxf(s0[2], s0[3]), s1[1]);
    a = fmaxf(fmaxf(a, s1[2]), s1[3]);
#pragma unroll
    for (int i = 4; i < 16; i += 4) { a = fmaxf(fmaxf(a, s0[i]), s0[i + 1]); b = fmaxf(fmaxf(b, s0[i + 2]), s0[i + 3]); a = fmaxf(fmaxf(a, s1[i]), s1[i + 1]); b = fmaxf(fmaxf(b, s1[i + 2]), s1[i + 3]); }
    return xor32_max(fmaxf(a, b));
}
__device__ __forceinline__ void att_exp(f32x16& s0, f32x16& s1, float mhat, float& lrun, bf16x8 (&pf)[4]) {
    float p0 = 0.f, p1 = 0.f;
#pragma unroll
    for (int i = 0; i < 16; ++i) { s0[i] = __builtin_amdgcn_exp2f(s0[i] - mhat); s1[i] = __builtin_amdgcn_exp2f(s1[i] - mhat); p0 += s0[i]; p1 += s1[i]; }
    lrun += p0 + p1;
    pf[0] = pack8((f32x4){s0[0], s0[1], s0[2], s0[3]}, (f32x4){s0[4], s0[5], s0[6], s0[7]});
    pf[1] = pack8((f32x4){s0[8], s0[9], s0[10], s0[11]}, (f32x4){s0[12], s0[13], s0[14], s0[15]});
    pf[2] = pack8((f32x4){s1[0], s1[1], s1[2], s1[3]}, (f32x4){s1[4], s1[5], s1[6], s1[7]});
    pf[3] = pack8((f32x4){s1[8], s1[9], s1[10], s1[11]}, (f32x4){s1[12], s1[13], s1[14], s1[15]});
}
__device__ __forceinline__ void att_pv(f32x16 (&o)[4], const LAS unsigned char* vslot, int va, const bf16x8 (&pf)[4]) {
#pragma unroll
    for (int db = 0; db < 4; ++db)
#pragma unroll
        for (int kk = 0; kk < 4; ++kk) {
            const bf16x8 v = *(const LAS bf16x8*)(vslot + ((va ^ (kk * 32)) + db * 4096));
            o[db] = MFMA32(v, pf[kk], o[db]);
        }
}

__device__ __forceinline__ void att1_load(bf16x8 (&kf)[8], bf16x8 (&vf)[8], const LAS unsigned char* kslot, int ka, const LAS unsigned char* vslot, int va) {
#pragma unroll
    for (int ks = 0; ks < 4; ++ks) { const LAS unsigned char* p = kslot + (ka ^ (ks * 32)); kf[2 * ks] = *(const LAS bf16x8*)p; kf[2 * ks + 1] = *(const LAS bf16x8*)(p + 32 * 256); }
#pragma unroll
    for (int kk = 0; kk < 2; ++kk)
#pragma unroll
        for (int db = 0; db < 4; ++db) vf[kk * 4 + db] = *(const LAS bf16x8*)(vslot + ((va ^ (kk * 32)) + db * 4096));
}
__device__ __forceinline__ void att1_load2(bf16x8 (&vg)[8], const LAS unsigned char* vslot, int va) {
#pragma unroll
    for (int kk = 2; kk < 4; ++kk)
#pragma unroll
        for (int db = 0; db < 4; ++db) vg[(kk - 2) * 4 + db] = *(const LAS bf16x8*)(vslot + ((va ^ (kk * 32)) + db * 4096));
}
__device__ __forceinline__ void att1_qk(f32x16& s0, f32x16& s1, const bf16x8 (&kf)[8], const bf16x8 (&qf)[4]) {
    f32x16 z;
#pragma unroll
    for (int i = 0; i < 16; ++i) z[i] = 0.f;
    s0 = MFMA32(kf[0], qf[0], z); s1 = MFMA32(kf[1], qf[0], z);
#pragma unroll
    for (int ks = 1; ks < 4; ++ks) { s0 = MFMA32(kf[2 * ks], qf[ks], s0); s1 = MFMA32(kf[2 * ks + 1], qf[ks], s1); }
}
__device__ __forceinline__ void att1_pv(f32x16 (&o)[4], const bf16x8 (&vf)[8], const bf16x8 (&vg)[8], const bf16x8 (&pf)[4]) {
#pragma unroll
    for (int kk = 0; kk < 2; ++kk)
#pragma unroll
        for (int db = 0; db < 4; ++db) o[db] = MFMA32(vf[kk * 4 + db], pf[kk], o[db]);
#pragma unroll
    for (int kk = 2; kk < 4; ++kk)
#pragma unroll
        for (int db = 0; db < 4; ++db) o[db] = MFMA32(vg[(kk - 2) * 4 + db], pf[kk], o[db]);
}
template <int MODE>
__device__ __forceinline__ void attn_phase(LAS unsigned char* lds, const bf16* Qp, const bf16* Kp, const bf16* KPEp, const bf16* Vtp, bf16* CAT, float lam, int vcu, int G) {
    constexpr int NKS = MODE == 0 ? 12 : 4;
    constexpr int RB = MODE == 0 ? 384 : 256;
    constexpr int KB = 64 * RB, VB = 128 * 128;
    constexpr int NKI = MODE == 0 ? 3 : 2;
    constexpr int NUNITS = MODE == 0 ? 512 : 2048;
    constexpr float THR = 8.f;
    const unsigned lds0 = (unsigned)(uintptr_t)lds;
    for (int unit = vcu; unit < NUNITS; unit += G) {
        int tid_ = threadIdx.x; asm volatile("" : "+v"(tid_)); const int tid = tid_, lane = tid & 63, wave = __builtin_amdgcn_readfirstlane(tid >> 6), r = lane & 31, hh = lane >> 5;
        int b, h, q0, wq, map, bh;
        if (MODE == 0) { const int qb = unit & 31; bh = unit >> 5; b = bh >> 2; h = bh & 3; q0 = qb * 256; wq = wave; map = 0; }
        else { const int qb = unit & 63; bh = unit >> 6; b = bh >> 3; h = bh & 7; q0 = qb * 128; wq = wave & 3; map = wave >> 2; }
        const size_t rowbase = (size_t)b * SEQ;
        const size_t qrow = rowbase + q0 + 32 * wq + r;
        bf16x8 qf[NKS];
        {
            const bf16* qp = MODE == 0 ? Qp + qrow * 768 + h * 192 + 8 * hh : Qp + qrow * 1024 + (2 * h + map) * 64 + 8 * hh;
#pragma unroll
            for (int ks = 0; ks < NKS; ++ks) qf[ks] = *(const bf16x8*)(qp + 16 * ks);
        }
        const bf16* kp[NKI]; int kadv[NKI];
#pragma unroll
        for (int n = 0; n < NKI; ++n) {
            const int P = 64 * (wave + 8 * n) + lane;
            if (MODE == 0) {
                const int row = P / 24, cp = P - row * 24, c = (cp & ~7) | ((cp & 7) ^ ((row >> 1) & 7));
                if (c < 16) { kp[n] = Kp + (rowbase + row) * 512 + h * 128 + c * 8; kadv[n] = 64 * 512; }
                else { kp[n] = KPEp + (rowbase + row) * 64 + (c - 16) * 8; kadv[n] = 64 * 64; }
            } else {
                const int row = P >> 4, c = (P & 15) ^ (row & 15);
                kp[n] = Kp + (rowbase + row) * 1024 + h * 128 + c * 8; kadv[n] = 64 * 1024;
            }
        }
        const bf16* vp[2];
#pragma unroll
        for (int n = 0; n < 2; ++n) { const int P = 64 * (wave + 8 * n) + lane, dv = P >> 3, c = (P & 7) ^ ((dv >> 1) & 7); vp[n] = Vtp + ((size_t)(bh * 128 + dv)) * SEQ + c * 8; }
        const unsigned kdma = lds0 + wave * 1024, vdma = lds0 + 3 * KB + wave * 1024;
#define ATT_DMA_K(slotoff) do { _Pragma("unroll") for (int n = 0; n < NKI; ++n) glds16(kp[n], (unsigned)__builtin_amdgcn_readfirstlane(kdma + (slotoff) + n * 8192)); } while (0)
#define ATT_DMA_V(slotoff) do { _Pragma("unroll") for (int n = 0; n < 2; ++n) glds16(vp[n], (unsigned)__builtin_amdgcn_readfirstlane(vdma + (slotoff) + n * 8192)); } while (0)
#define ATT_ADV_K() do { _Pragma("unroll") for (int n = 0; n < NKI; ++n) kp[n] += kadv[n]; } while (0)
#define ATT_ADV_V() do { _Pragma("unroll") for (int n = 0; n < 2; ++n) vp[n] += 64; } while (0)
#define ATT_RESC_O() do { if (havepend) { _Pragma("unroll") for (int db = 0; db < 4; ++db) _Pragma("unroll") for (int i = 0; i < 16; ++i) o[db][i] *= fpend; havepend = false; } } while (0)
        const int ka = MODE == 0 ? r * RB + ((hh ^ ((r >> 1) & 7)) * 16) : r * RB + (((map * 8 + hh) ^ (r & 15)) * 16);
        const int va = r * 128 + ((hh ^ ((r >> 1) & 7)) * 16);
        const LAS unsigned char* vring = lds + 3 * KB;
        f32x16 o[4], S0, S1;
        bf16x8 pf[4];
#pragma unroll
        for (int db = 0; db < 4; ++db)
#pragma unroll
            for (int i = 0; i < 16; ++i) o[db][i] = 0.f;
        float mhat = 0.f, lrun = 0.f, fpend = 1.f; bool havepend = false;
        ATT_DMA_K(0); ATT_ADV_K(); ATT_DMA_K(KB); ATT_ADV_K(); ATT_DMA_V(0); ATT_ADV_V();
        asm volatile("s_waitcnt vmcnt(0) lgkmcnt(0)\n\ts_barrier" ::: "memory");
        int kr = 0, kw = 2 * KB, vr = 2 * VB, vw = VB;
        if constexpr (MODE == 1) {
            bf16x8 pfB[4];
            bf16x8 kf[8], vf[8], vg[8];
            float fp = 1.f; bool pend = false;
#define ATT1_ITER(PFP, PFN, I, DO_C) do { \
            const int i_ = (I); \
            att1_load(kf, vf, lds + kr, ka, vring + vr, va); \
            __builtin_amdgcn_sched_barrier(0); \
            att1_qk(S0, S1, kf, qf); \
            att1_load2(vg, vring + vr, va); \
            const float rm = att_rowmax(S0, S1); \
            if (!(DO_C)) mhat = rm; \
            else if (__any(rm - mhat > THR)) { const float dl = fmaxf(rm - mhat, 0.f); fp = __builtin_amdgcn_exp2f(-dl); lrun *= fp; mhat += dl; pend = true; } \
            if (DO_C) att1_pv(o, vf, vg, PFP); \
            att_exp(S0, S1, mhat, lrun, PFN); \
            if (DO_C) { _Pragma("unroll") for (int g_ = 0; g_ < 16; ++g_) { __builtin_amdgcn_sched_group_barrier(0x008, 1, 0); __builtin_amdgcn_sched_group_barrier(0x002, 7, 0); } } \
            if (pend) { _Pragma("unroll") for (int db = 0; db < 4; ++db) _Pragma("unroll") for (int e = 0; e < 16; ++e) o[db][e] *= fp; pend = false; } \
            ATT_DMA_K(kw); ATT_DMA_V(vw); \
            if (i_ + 2 < 127) ATT_ADV_K(); \
            if (i_ + 1 < 127) ATT_ADV_V(); \
            kr = (kr == 2 * KB) ? 0 : kr + KB; kw = (kw == 2 * KB) ? 0 : kw + KB; \
            vr = (vr == 2 * VB) ? 0 : vr + VB; vw = (vw == 2 * VB) ? 0 : vw + VB; \
            asm volatile("s_waitcnt vmcnt(4) lgkmcnt(0)\n\ts_barrier" ::: "memory"); } while (0)
            ATT1_ITER(pfB, pf, 0, false);
            for (int i2 = 1; i2 < 127; i2 += 2) {
                ATT1_ITER(pf, pfB, i2, true);
                ATT1_ITER(pfB, pf, i2 + 1, true);
            }
            ATT1_ITER(pf, pfB, 127, true);
#undef ATT1_ITER
#pragma unroll
            for (int q = 0; q < 4; ++q) pf[q] = pfB[q];
        } else {
        for (int i = 0; i < 128; ++i) {
            att_qk<MODE>(S0, S1, lds + kr, ka, qf);
            const float rm = att_rowmax(S0, S1);
            if (i == 0) mhat = rm;
            else if (__any(rm - mhat > THR)) { const float dl = fmaxf(rm - mhat, 0.f), f = __builtin_amdgcn_exp2f(-dl); lrun *= f; mhat += dl; fpend = f; havepend = true; }
            if (i > 0) att_pv(o, vring + vr, va, pf);
            att_exp(S0, S1, mhat, lrun, pf);
            ATT_RESC_O();
            ATT_DMA_K(kw); ATT_DMA_V(vw);
            if (i + 2 < 127) ATT_ADV_K();
            if (i + 1 < 127) ATT_ADV_V();
            kr = (kr == 2 * KB) ? 0 : kr + KB; kw = (kw == 2 * KB) ? 0 : kw + KB;
            vr = (vr == 2 * VB) ? 0 : vr + VB; vw = (vw == 2 * VB) ? 0 : vw + VB;
            asm volatile("s_waitcnt vmcnt(5) lgkmcnt(0)\n\ts_barrier" ::: "memory");
        }
        }
        att_pv(o, vring + vr, va, pf);
        asm volatile("s_waitcnt vmcnt(0) lgkmcnt(0)\n\ts_barrier" ::: "memory");
#undef ATT_DMA_K
#undef ATT_DMA_V
#undef ATT_ADV_K
#undef ATT_ADV_V
#undef ATT_RESC_O
        lrun = xor32_add(lrun);
        const float inv = 1.0f / lrun;
        bf16* orow = CAT + qrow * DM + h * 128;
        if (MODE == 0) {
#pragma unroll
            for (int db = 0; db < 4; ++db)
#pragma unroll
                for (int g4 = 0; g4 < 4; ++g4) {
                    const u32x2 w = {pk2(o[db][4 * g4] * inv, o[db][4 * g4 + 1] * inv), pk2(o[db][4 * g4 + 2] * inv, o[db][4 * g4 + 3] * inv)};
                    *(u32x2*)(orow + 32 * db + 8 * g4 + 4 * hh) = w;
                }
        } else {
            LAS float* ex = (LAS float*)lds + wq * 4096 + lane;
            if (map == 1) {
                const float f = lam * inv;
#pragma unroll
                for (int db = 0; db < 4; ++db)
#pragma unroll
                    for (int i = 0; i < 16; ++i) ex[(db * 16 + i) * 64] = o[db][i] * f;
            }
            __syncthreads();
            if (map == 0) {
                float ss = 0.f;
#pragma unroll
                for (int db = 0; db < 4; ++db)
#pragma unroll
                    for (int i = 0; i < 16; ++i) { const float v = o[db][i] * inv - ex[(db * 16 + i) * 64]; o[db][i] = v; ss += v * v; }
                ss = xor32_add(ss);
                const float rstd = rsqrtf(ss * (1.f / 128.f) + EPS);
#pragma unroll
                for (int db = 0; db < 4; ++db)
#pragma unroll
                    for (int g4 = 0; g4 < 4; ++g4) {
                        const u32x2 w = {pk2(o[db][4 * g4] * rstd, o[db][4 * g4 + 1] * rstd), pk2(o[db][4 * g4 + 2] * rstd, o[db][4 * g4 + 3] * rstd)};
                        *(u32x2*)(orow + 32 * db + 8 * g4 + 4 * hh) = w;
                    }
            }
            __syncthreads();
        }
    }
}

constexpr size_t WS_CTL = 5 * MiB, CTL_BYTES = 16384;
#define XB_TMO      128
#define XB_XCNT(j)  (256  + 64 * (j))
#define XB_XSUB(j)  (1280 + 64 * (j))
#define XB_XGEN(j)  (2304 + 64 * (j))
#define XB_TOP      3328
#define XB_TOPGEN   3392
#define XCD_BAR_WORDS 3456
#define XB_SPIN_CAP (1u << 18)

__device__ __forceinline__ unsigned xb_ld(unsigned* p)              { return __hip_atomic_load(p, __ATOMIC_RELAXED, __HIP_MEMORY_SCOPE_AGENT); }
__device__ __forceinline__ unsigned xb_add(unsigned* p, unsigned v) { return __hip_atomic_fetch_add(p, v, __ATOMIC_RELAXED, __HIP_MEMORY_SCOPE_AGENT); }
__device__ __forceinline__ unsigned xb_xcc_id() { return (unsigned)__builtin_amdgcn_s_getreg((3 << 11) | 20) & 0xFu; }
#define XB_SPIN(cond, bar) do { unsigned _sp = 0; while (cond) { __builtin_amdgcn_s_sleep(1); \
    if ((++_sp & 255u) == 0u) { if (xb_ld(&(bar)[XB_TMO])) break; if (_sp > XB_SPIN_CAP) { atomicAdd(&(bar)[XB_TMO], 1u); break; } } } } while (0)

struct XcdBarrier {
    unsigned* bar; unsigned x;
    volatile LAS unsigned* st;
};

__device__ __forceinline__ XcdBarrier xcd_barrier_post(unsigned* bar, volatile LAS unsigned* st) {
    XcdBarrier b; b.bar = bar; b.x = xb_xcc_id(); b.st = st;
    if (threadIdx.x == 0) (void)xb_add(&bar[XB_XCNT(b.x)], 1u);
    return b;
}
__device__ __forceinline__ void xcd_barrier_complete(unsigned* bar, unsigned x, unsigned& nloc, unsigned& nx) {
    const unsigned G = gridDim.x * gridDim.y * gridDim.z;
    unsigned sum, cnt, mine, sp = 0u;
    for (;;) {
        sum = 0u; cnt = 0u; mine = 0u;
#pragma unroll
        for (unsigned j = 0; j < 16; ++j) { const unsigned c = xb_ld(&bar[XB_XCNT(j)]); sum += c; cnt += (c > 0u) ? 1u : 0u; mine = (j == x) ? c : mine; }
        if (sum == G) break;
        __builtin_amdgcn_s_sleep(1);
        if ((++sp & 255u) == 0u) { if (xb_ld(&bar[XB_TMO])) break; if (sp > XB_SPIN_CAP) { atomicAdd(&bar[XB_TMO], 1u); break; } }
    }
    nloc = mine > 0u ? mine : 1u; nx = cnt > 0u ? cnt : 1u;
}

__device__ __forceinline__ void xcd_barrier(const XcdBarrier& b) {
    asm volatile("s_waitcnt vmcnt(0)" ::: "memory");
    __syncthreads();
    if (threadIdx.x == 0) {
        unsigned* bar = b.bar;
        __builtin_amdgcn_s_waitcnt(0);
        unsigned nloc = b.st[0], nx = b.st[1];
        if (nloc == 0u) { xcd_barrier_complete(bar, b.x, nloc, nx); b.st[0] = nloc; b.st[1] = nx; }
        const unsigned old = xb_add(&bar[XB_XSUB(b.x)], 1u);
        const unsigned gen = old / nloc;
        if (old + 1u == (gen + 1u) * nloc) {
            __builtin_amdgcn_fence(__ATOMIC_RELEASE, "agent");
            asm volatile("s_waitcnt vmcnt(0)" ::: "memory");
            const unsigned og = xb_add(&bar[XB_TOP], 1u);
            const unsigned tg = og / nx;
            if (og + 1u == (tg + 1u) * nx) xb_add(&bar[XB_TOPGEN], 1u);
            else XB_SPIN(xb_ld(&bar[XB_TOPGEN]) == tg, bar);
            __builtin_amdgcn_fence(__ATOMIC_ACQUIRE, "agent");
            xb_add(&bar[XB_XGEN(b.x)], 1u);
            asm volatile("s_waitcnt vmcnt(0)" ::: "memory");
        } else {
            XB_SPIN(xb_ld(&bar[XB_XGEN(b.x)]) == gen, bar);
            __builtin_amdgcn_fence(__ATOMIC_ACQUIRE, "agent");
            asm volatile("s_waitcnt vmcnt(0)" ::: "memory");
        }
    }
    __syncthreads();
}

#ifndef MK_SINGLE
#define MK_SINGLE 1
#endif
constexpr int NPHASES = 47;
constexpr int LDS_BYTES = 147456;
struct Args { const float* in[34]; float* out; unsigned char* ws; double inv_m[32]; double inv_d[8]; int lo, hi; };

__global__ void __launch_bounds__(512, 2) mk_fwd(Args args) {
    extern __shared__ __attribute__((aligned(16))) unsigned char lds_raw[];
    LAS unsigned char* lds = (LAS unsigned char*)lds_raw;
    cg::grid_group grid = cg::this_grid();
    volatile LAS unsigned* xst = (volatile LAS unsigned*)(lds + 147456 - 64);
    if (threadIdx.x < 2) xst[threadIdx.x] = 0u;
    __syncthreads();
    if (args.hi - args.lo > 1) (void)xcd_barrier_post((unsigned*)(args.ws + WS_CTL), xst);
    const int lo = args.lo, hi = args.hi;
    int ph = 0;
#define PH_BEGIN if (ph >= lo && ph < hi) { \
    int tid_ = threadIdx.x; asm volatile("" : "+v"(tid_)); int zz_ = 0; asm volatile("" : "+s"(zz_)); \
    const int tid = tid_, lane = tid & 63, wave = __builtin_amdgcn_readfirstlane(tid >> 6); \
    const int G = gridDim.x, bx = blockIdx.x + zz_; \
    const int vcu = (G % 8 == 0) ? (bx % 8) * (G / 8) + bx / 8 : bx; \
    const int gw = bx * 8 + wave, NGW = G * 8; \
    unsigned char* ws = args.ws + zz_; \
    float* cosm = (float*)(ws + WS_COSM); float* sinm = (float*)(ws + WS_SINM); float* cosd = (float*)(ws + WS_COSD); float* sind = (float*)(ws + WS_SIND); \
    float2* s5A = (float2*)(ws + WS_S5A); float2* s5A64 = (float2*)(ws + WS_S5A64); bf16* s5BB = (bf16*)(ws + WS_S5BB); bf16* s5CT = (bf16*)(ws + WS_S5CT); \
    float* lamtab = (float*)(ws + WS_LAM); \
    bf16* Wb = (bf16*)(ws + WS_W); \
    bf16* XN = (bf16*)(ws + WS_XN); bf16* CAT = XN; \
    unsigned char* R1 = ws + WS_R1; \
    bf16* Hb = (bf16*)(R1 + R_H); \
    float* ZA = (float*)(R1 + R_ZA); float* Ub = (float*)(R1 + R_U); \
    bf16* Qb = (bf16*)(R1 + R_Q); bf16* KNb = (bf16*)(R1 + R_KN); bf16* VTb = (bf16*)(R1 + R_VT); \
    bf16* ZQN = (bf16*)(R1 + R_ZQN); bf16* ZKVN = (bf16*)(R1 + R_ZKVN); bf16* KPE = (bf16*)(R1 + R_KPE); bf16* YGb = (bf16*)(R1 + R_YGB); \
    float2* SLOC = (float2*)(R1 + R_SLOC); float2* CARRY = (float2*)(R1 + R_CARRY); \
    bf16* QD = (bf16*)(R1 + R_QD); bf16* KD = (bf16*)(R1 + R_KD); bf16* VTD = (bf16*)(R1 + R_VTD); \
    float* X = args.out + zz_; \
    const int j = (layer_ >> 1) + zz_; (void)j; \
    bf16* wl = Wb + (size_t)(layer_ + zz_) * W_FFN_L; bf16* we = Wb + W_EVEN0 + (size_t)j * W_EVEN_L; bf16* wo = Wb + W_ODD0 + (size_t)j * W_ODD_L; const int tb = j * 64; \
    (void)tid; (void)lane; (void)wave; (void)vcu; (void)gw; (void)NGW; (void)cosm; (void)sinm; (void)cosd; (void)sind; (void)s5A; (void)s5A64; (void)s5BB; (void)s5CT; (void)lamtab; (void)Wb; (void)XN; (void)CAT; \
    (void)Hb; (void)ZA; (void)Ub; (void)Qb; (void)KNb; (void)VTb; (void)ZQN; (void)ZKVN; (void)KPE; (void)YGb; (void)SLOC; (void)CARRY; (void)QD; (void)KD; (void)VTD; (void)X; (void)wl; (void)we; (void)wo; (void)tb;
#define PH_END   if (ph + 1 < hi) { if (hi < 0) grid.sync();   else { XcdBarrier xb_; xb_.bar = (unsigned*)ws + WS_CTL / 4; xb_.x = xb_xcc_id(); xb_.st = (volatile LAS unsigned*)(lds + 147456 - 64); xcd_barrier(xb_); } } } ++ph;
    int layer_ = 0;

    PH_BEGIN
#pragma unroll 1
        for (int i = 0; i < 4; ++i) {
            bf16* wlp = Wb + (size_t)i * W_FFN_L;
            const size_t o1 = (size_t)i * DM * FF;
            prep_w(args.in[2] + o1, DM, FF, wlp + W_GU1, 4, 1, 0, args.in[1] + i * DM, 0x7fffffff, 1.f, gw, NGW, lane, (LAS float*)(lds + wave * 8704));
            prep_w(args.in[3] + o1, DM, FF, wlp + W_GU1, 4, 1, 128, args.in[1] + i * DM, 0x7fffffff, 1.f, gw, NGW, lane, (LAS float*)(lds + wave * 8704));
            prep_w(args.in[4] + o1, FF, DM, wlp + W_D1, 0, 1, 0, nullptr, 0, 0.5f, gw, NGW, lane, (LAS float*)(lds + wave * 8704));
            prep_w(args.in[7] + o1, DM, FF, wlp + W_GU2, 4, 1, 0, args.in[6] + i * DM, 0x7fffffff, 1.f, gw, NGW, lane, (LAS float*)(lds + wave * 8704));
            prep_w(args.in[8] + o1, DM, FF, wlp + W_GU2, 4, 1, 128, args.in[6] + i * DM, 0x7fffffff, 1.f, gw, NGW, lane, (LAS float*)(lds + wave * 8704));
            prep_w(args.in[9] + o1, FF, DM, wlp + W_D2, 0, 1, 0, nullptr, 0, 0.5f, gw, NGW, lane, (LAS float*)(lds + wave * 8704));
        }
#pragma unroll 1
        for (int jj = 0; jj < 2; ++jj) { const int j = jj;
            bf16* we = Wb + W_EVEN0 + (size_t)j * W_EVEN_L;
            prep_w(args.in[10] + (size_t)j * DM * 1344, DM, 1344, we + W_WIN, 0, 1, 0, args.in[5] + (2 * j) * DM, 0x7fffffff, 1.f, gw, NGW, lane, (LAS float*)(lds + wave * 8704));
            for (int idx = gw * 64 + lane; idx < 192 * DM / 8; idx += NGW * 64) ((u32x4*)(we + W_WIN + (size_t)1344 * DM))[idx] = (u32x4){0u, 0u, 0u, 0u};
            prep_w(args.in[12] + (size_t)j * 512 * 768, 512, 768, we + W_QUP, 2, 1, 0, args.in[11] + j * 512, 0x7fffffff, 1.f, gw, NGW, lane, (LAS float*)(lds + wave * 8704));
            prep_w(args.in[14] + (size_t)j * 256 * 1024, 256, 1024, we + W_KVUP, 0, 1, 0, args.in[13] + j * 256, 0x7fffffff, 1.f, gw, NGW, lane, (LAS float*)(lds + wave * 8704));
            prep_w(args.in[23] + (size_t)j * 512 * 512, 512, 512, we + W_GLU, 0, 1, 0, nullptr, 0, 1.f, gw, NGW, lane, (LAS float*)(lds + wave * 8704));
            prep_w(args.in[25] + (size_t)j * DM * DM, DM, DM, we + W_WOUT, 0, 1, 0, nullptr, 0, 1.f, gw, NGW, lane, (LAS float*)(lds + wave * 8704));
            bf16* wo = Wb + W_ODD0 + (size_t)j * W_ODD_L;
            const float lam_init = 0.8f - 0.6f * expf(-0.3f * (float)(2 * j + 1));
            prep_w(args.in[26] + (size_t)j * DM * 3072, DM, 3072, wo + W_DIN, 3, 1, 0, args.in[5] + (2 * j + 1) * DM, 0x7fffffff, 1.f, gw, NGW, lane, (LAS float*)(lds + wave * 8704));
            prep_w(args.in[32] + (size_t)j * DM * DM, DM, DM, wo + W_DOUT, 0, 1, 0, args.in[31] + j * 128, 127, 1.f - lam_init, gw, NGW, lane, (LAS float*)(lds + wave * 8704));
        }
        for (int idx = bx * 512 + tid; idx < SEQ * 32; idx += G * 512) {
            const int pos = idx >> 5, t = idx & 31;
            const double rev = (double)pos * args.inv_m[t] * 0.15915494309189535; const float fr = (float)(rev - rint(rev));
            cosm[idx] = __builtin_amdgcn_cosf(fr); sinm[idx] = __builtin_amdgcn_sinf(fr);
        }
        for (int idx = bx * 512 + tid; idx < SEQ * 8; idx += G * 512) {
            const int pos = idx >> 3, t = idx & 7;
            const double rev = (double)pos * args.inv_d[t] * 0.15915494309189535; const float fr = (float)(rev - rint(rev));
            cosd[idx] = __builtin_amdgcn_cosf(fr); sind[idx] = __builtin_amdgcn_sinf(fr);
        }
        for (int idx = bx * 512 + tid; idx < 8192; idx += G * 512) {
            const int p = idx & 63, g = (idx >> 6) & 31, jd = idx >> 11;
            const float lr = args.in[15][idx], li = args.in[16][idx];
            const float dt = __expf(args.in[17][jd * 32 + g]);
            const float mag = __expf(lr * dt);
            const double rev = (double)(li * dt) * 0.15915494309189535; const float fr = (float)(rev - rint(rev));
            const float ar = mag * __builtin_amdgcn_cosf(fr), ai = mag * __builtin_amdgcn_sinf(fr);
            const float den = lr * lr + li * li, nr = ar - 1.0f;
            const float cre = (nr * lr + ai * li) / den, cim = (ai * lr - nr * li) / den;
            s5A[idx] = make_float2(ar, ai);
            float pr = ar, pi = ai;
#pragma unroll
            for (int q = 0; q < 6; ++q) { const float tr = pr * pr - pi * pi, ti = 2.f * pr * pi; pr = tr; pi = ti; }
            s5A64[idx] = make_float2(pr, pi);
            const float* br = args.in[18] + (size_t)idx * 16; const float* bi = args.in[19] + (size_t)idx * 16;
            const int colp = p & 31, half = p >> 5;
            bf16* bre = s5BB + ((size_t)(jd * 32 + g) * 128 + (2 * half) * 32 + colp) * 16;
            bf16* bim = s5BB + ((size_t)(jd * 32 + g) * 128 + (2 * half + 1) * 32 + colp) * 16;
#pragma unroll
            for (int c = 0; c < 16; c += 2) {
                const float r0 = cre * br[c] - cim * bi[c], r1 = cre * br[c + 1] - cim * bi[c + 1];
                const float i0 = cre * bi[c] + cim * br[c], i1 = cre * bi[c + 1] + cim * br[c + 1];
                *(unsigned*)(bre + c) = pk2(r0, r1); *(unsigned*)(bim + c) = pk2(i0, i1);
            }
            const float* cr = args.in[20] + (size_t)(jd * 32 + g) * 1024; const float* ci = args.in[21] + (size_t)(jd * 32 + g) * 1024;
            bf16* ct = s5CT + (size_t)(jd * 32 + g) * 2048;
#pragma unroll 4
            for (int c = 0; c < 16; ++c) *(unsigned*)(ct + c * 128 + 4 * colp + 2 * half) = pk2(cr[c * 64 + p], -ci[c * 64 + p]);
        }
        if (bx == 0 && tid < 2) {
            const int j = tid; float d1 = 0.f, d2 = 0.f;
            for (int e = 0; e < 64; ++e) { d1 += args.in[27][j * 64 + e] * args.in[28][j * 64 + e]; d2 += args.in[29][j * 64 + e] * args.in[30][j * 64 + e]; }
            lamtab[j] = expf(d1) - expf(d2) + (0.8f - 0.6f * expf(-0.3f * (float)(2 * j + 1)));
        }
        norm_rows(args.in[0], XN, gw, NGW, lane);
    PH_END

#pragma unroll 1
    for (int layer = 0; layer < 4; ++layer) {
        layer_ = layer;
#pragma unroll 1
        for (int half = 0; half < 2; ++half) {
            if (half == 1) {
                PH_BEGIN norm_rows(X, XN, gw, NGW, lane); PH_END
                if ((layer & 1) == 0) {
                    PH_BEGIN {
                        pg8::Gemm g{XN, we + W_WIN, M, ZN, DM}; pg8::StaticOrder S; S.init(M, ZN, G, bx);
                        EpiZ E{ZA, Ub};
                        pg8::gemm_phase<EpiZ, pg8::StaticOrder, true, true>(lds, g, S, E);
                    } PH_END
                    PH_BEGIN
                        post_rows(ZA, ZQN, ZKVN, KPE, cosm, sinm, gw, NGW, lane);
                        s5_pass<false>(lds + wave * 8704, Ub, s5A + (size_t)tb * 64, s5BB + (size_t)tb * 2048, s5CT + (size_t)tb * 2048, SLOC, CARRY, nullptr, nullptr, gw, NGW, lane);
                    PH_END
                    PH_BEGIN
                        s5_passB(s5A64 + (size_t)tb * 64, SLOC, CARRY);
                        {
                            pg8::Gemm g{ZQN, we + W_QUP, M, 768, 512}; pg8::StaticOrder S; S.init(M, 768, G, bx);
                            EpiQ E{Qb, cosm, sinm, 0.07216878364870322f * LOG2E};
                            pg8::gemm_phase<EpiQ, pg8::StaticOrder, true, false>(lds, g, S, E);
                        }
                        {
                            pg8::Gemm g{ZKVN, we + W_KVUP, M, 1024, 256}; pg8::StaticOrder S; S.init(M, 1024, G, bx);
                            EpiKV E{KNb, VTb};
                            pg8::gemm_phase<EpiKV, pg8::StaticOrder, true, false>(lds, g, S, E);
                        }
                    PH_END
                    PH_BEGIN
                        attn_phase<0>(lds, Qb, KNb, KPE, VTb, CAT, 0.f, vcu, G);
                        s5_pass<true>(lds + wave * 8704, Ub, s5A + (size_t)tb * 64, s5BB + (size_t)tb * 2048, s5CT + (size_t)tb * 2048, SLOC, CARRY, args.in[22] + j * 512, YGb, gw, NGW, lane);
                    PH_END
                    PH_BEGIN {
                        pg8::Gemm g{YGb, we + W_GLU, M, 512, 512}; pg8::StaticOrder S; S.init(M, 512, G, bx);
                        EpiGlu E{YGb, args.in[24] + j * 512, CAT};
                        pg8::gemm_phase<EpiGlu, pg8::StaticOrder, true, false>(lds, g, S, E);
                    } PH_END
                    PH_BEGIN {
                        pg8::Gemm g{CAT, we + W_WOUT, M, DM, DM}; pg8::StaticOrder S; S.init(M, DM, G, bx);
                        EpiResid E{X, X};
                        pg8::gemm_phase<EpiResid, pg8::StaticOrder, true, true>(lds, g, S, E);
                    } PH_END
                } else {
                    PH_BEGIN {
                        pg8::Gemm g{XN, wo + W_DIN, M, 3072, DM}; pg8::StaticOrder S; S.init(M, 3072, G, bx);
                        EpiDiffIn E{QD, KD, VTD, cosd, sind, 0.125f * LOG2E};
                        pg8::gemm_phase<EpiDiffIn, pg8::StaticOrder, true, true>(lds, g, S, E);
                    } PH_END
                    PH_BEGIN
                        attn_phase<1>(lds, QD, KD, nullptr, VTD, CAT, lamtab[j], vcu, G);
                    PH_END
                    PH_BEGIN {
                        pg8::Gemm g{CAT, wo + W_DOUT, M, DM, DM}; pg8::StaticOrder S; S.init(M, DM, G, bx);
                        EpiResid E{X, X};
                        pg8::gemm_phase<EpiResid, pg8::StaticOrder, true, true>(lds, g, S, E);
                    } PH_END
                }
                PH_BEGIN norm_rows(X, XN, gw, NGW, lane); PH_END
            }
            PH_BEGIN {
                pg8::Gemm g{XN, wl + (half ? W_GU2 : W_GU1), M, NGU, DM}; pg8::StaticOrder S; S.init(M, NGU, G, bx);
                EpiSwiglu E{Hb};
                pg8::gemm_phase<EpiSwiglu, pg8::StaticOrder, true, true>(lds, g, S, E);
            } PH_END
            PH_BEGIN {
                pg8::Gemm g{Hb, wl + (half ? W_D2 : W_D1), M, DM, FF}; pg8::StaticOrder S; S.init(M, DM, G, bx);
                EpiResid E{(layer == 0 && half == 0) ? args.in[0] : (const float*)X, X};
                pg8::gemm_phase<EpiResid, pg8::StaticOrder, true, true>(lds, g, S, E);
            } PH_END
        }
        if (layer < 3) { PH_BEGIN norm_rows(X, XN, gw, NGW, lane); PH_END }
    }
    PH_BEGIN final_norm_rows(X, args.in[33], gw, NGW, lane); PH_END
#undef PH_BEGIN
#undef PH_END
}

extern "C" void kernel_launch(void* const* d_in, const int* in_sizes, int n_in, void* d_out, int out_size, void* d_ws, size_t ws_size, hipStream_t stream) {
    static int grid = 0;
    if (grid == 0) {
        if (n_in != 34 || out_size != M * DM || ws_size < WS_NEED) { fprintf(stderr, "kernel_launch: unexpected shapes (n_in %d out %d ws %zu)\n", n_in, out_size, ws_size); grid = -1; return; }
        int dev = 0, cus = 0, per_cu = 0;
        (void)hipGetDevice(&dev); (void)hipDeviceGetAttribute(&cus, hipDeviceAttributeMultiprocessorCount, dev);
        if (hipFuncSetAttribute((const void*)mk_fwd, hipFuncAttributeMaxDynamicSharedMemorySize, LDS_BYTES) != hipSuccess) { fprintf(stderr, "kernel_launch: hipFuncSetAttribute failed\n"); grid = -1; return; }
        if (hipOccupancyMaxActiveBlocksPerMultiprocessor(&per_cu, (const void*)mk_fwd, 512, LDS_BYTES) != hipSuccess || per_cu < 1) { fprintf(stderr, "kernel_launch: occupancy query says %d\n", per_cu); per_cu = 1; }
        (void)hipGetLastError();
        grid = cus * 1;
        if (grid <= 0) grid = 256;
    }
    if (grid < 0) return;
    (void)hipMemsetAsync((unsigned char*)d_ws + WS_CTL, 0, CTL_BYTES, stream);
    Args a; memset(&a, 0, sizeof(a));
    for (int i = 0; i < 34; ++i) a.in[i] = (const float*)d_in[i];
    a.out = (float*)d_out; a.ws = (unsigned char*)d_ws;
    for (int t = 0; t < 32; ++t) a.inv_m[t] = pow(500000.0, -(double)(2 * t) / 64.0);
    for (int t = 0; t < 8; ++t) a.inv_d[t] = pow(500000.0, -(double)(2 * t) / 16.0);
#if MK_SINGLE
    a.lo = 0; a.hi = NPHASES;
    void* kargs[] = {&a};
    hipError_t e = hipLaunchCooperativeKernel((const void*)mk_fwd, dim3(grid), dim3(512), kargs, LDS_BYTES, stream);
    if (e != hipSuccess) fprintf(stderr, "kernel_launch: cooperative launch failed: %s (grid %d)\n", hipGetErrorString(e), grid);
#else
    for (int p = 0; p < NPHASES; ++p) {
        a.lo = p; a.hi = p + 1;
        hipLaunchKernelGGL(mk_fwd, dim3(grid), dim3(512), LDS_BYTES, stream, a);
    }
#endif
}
```
